# Optimizing an MI355X kernel written in HIP

```python
import jax, jax.numpy as jnp
from jax import lax
import numpy as np

D_MODEL = 1024
BATCH = 2
SEQ = 16384
DEPTH = 2

MEM_LEN = 256
EPS = 1e-6
CONV_A_WIDTH = D_MODEL // 2
CONV_A_KERNEL = 31
DIL_PATTERNS = ((128, 1), (512, 4), (2048, 16))
DIL_GROUPS = len(DIL_PATTERNS)
DIL_HEADS = 4
DIL_HEAD_DIM = 64
DIL_WIDTH = DIL_GROUPS * DIL_HEADS * DIL_HEAD_DIM
DIL_OUT = DIL_HEADS * DIL_HEAD_DIM
BLOCK = 128
SC_WIDTH = D_MODEL // 2
SC_KERNEL = 3
N_BRANCH = 3
OFF_A = 0
OFF_Q = OFF_A + 2 * CONV_A_WIDTH
OFF_K = OFF_Q + DIL_WIDTH
OFF_V = OFF_K + DIL_WIDTH
OFF_CB = OFF_V + DIL_WIDTH
OFF_CC = OFF_CB + SC_WIDTH
OFF_CH = OFF_CC + SC_WIDTH
OFF_G = OFF_CH + SC_WIDTH
N_IN = OFF_G + N_BRANCH * D_MODEL
XATTN_HEADS = 4
XATTN_HEAD_DIM = D_MODEL // XATTN_HEADS
D_FF = ((8 * D_MODEL // 3 + 255) // 256) * 256
N_EXPERTS = 8
TOP_K = 2
MOE_FF = 7 * D_MODEL // 2
N_DENSE = (DEPTH + 1) // 2
N_MOE = DEPTH // 2

kernel_name = "hybrid_conv_dilated_shortconv_moe_block"


def rms_norm(x, g):
    x32 = x.astype(jnp.float32)
    y = x32 * lax.rsqrt(jnp.mean(x32 * x32, axis=-1, keepdims=True) + EPS)
    return (y * g.astype(jnp.float32)).astype(x.dtype)


def layer_norm(x, g, b):
    x32 = x.astype(jnp.float32)
    mu = jnp.mean(x32, axis=-1, keepdims=True)
    xc = x32 - mu
    y = xc * lax.rsqrt(jnp.mean(xc * xc, axis=-1, keepdims=True) + EPS)
    return (y * g.astype(jnp.float32) + b.astype(jnp.float32)).astype(x.dtype)


def causal_depthwise_conv(u, w):
    k_width, c = w.shape
    return lax.conv_general_dilated(
        u, w.astype(u.dtype)[:, None, :], window_strides=(1,), padding=[(k_width - 1, 0)],
        dimension_numbers=("NWC", "WIO", "NWC"), feature_group_count=c)


def dilated_window_attention(q, k, v, dilation, n_steps):
    b, s, h, dh = q.shape
    span = dilation * BLOCK
    s_pad = -(-s // span) * span
    nb = s_pad // span
    pad = [(0, 0), (0, s_pad - s), (0, 0), (0, 0)]

    def blocks(t):
        return jnp.pad(t, pad).reshape(b, nb, BLOCK, dilation, h, dh)

    def band(t):
        prev = jnp.pad(t[:, :-1], [(0, 0), (1, 0), (0, 0), (0, 0), (0, 0), (0, 0)])
        return jnp.concatenate([prev, t], axis=2)

    qb = blocks(q)
    kw, vw = band(blocks(k)), band(blocks(v))
    scores = jnp.einsum('bnqrhe,bnkrhe->bnrhqk', qb, kw) * (dh ** -0.5)
    qi = jnp.arange(BLOCK)[:, None]
    kj = jnp.arange(2 * BLOCK)[None, :]
    dist = BLOCK + qi - kj
    in_band = (dist >= 0) & (dist <= n_steps)
    has_prev = jnp.arange(nb)[:, None, None] > 0
    valid = in_band[None] & (has_prev | (kj >= BLOCK)[None])
    scores = jnp.where(valid[None, :, None, None], scores, -jnp.inf)
    m = jnp.max(scores, axis=-1, keepdims=True)
    p = jnp.exp(scores - m)
    den = jnp.sum(p, axis=-1, keepdims=True)
    out = jnp.einsum('bnrhqk,bnkrhe->bnqrhe', p / den, vw)
    lse = (m + jnp.log(den))[..., 0]
    out = out.reshape(b, s_pad, h, dh)[:, :s]
    lse = lse.transpose(0, 1, 4, 2, 3).reshape(b, s_pad, h)[:, :s]
    return out, lse


def hybrid_mixer(h, w_in, b_in, a_conv_w, a_conv_b, a_ln_g, a_ln_b, a_w_out,
                 b_w_out, c_conv_w, c_w_out, w_o):
    bsz, s, _ = h.shape
    z = h @ w_in + b_in
    a = z[..., OFF_A:OFF_A + CONV_A_WIDTH] * jax.nn.sigmoid(z[..., OFF_A + CONV_A_WIDTH:OFF_Q])
    a = causal_depthwise_conv(a, a_conv_w) + a_conv_b
    y_a = jax.nn.silu(layer_norm(a, a_ln_g, a_ln_b)) @ a_w_out
    def heads(t):
        return t.reshape(bsz, s, DIL_GROUPS, DIL_HEADS, DIL_HEAD_DIM).astype(jnp.float32)
    q, k, v = heads(z[..., OFF_Q:OFF_K]), heads(z[..., OFF_K:OFF_V]), heads(z[..., OFF_V:OFF_CB])
    outs, lses = [], []
    for g, (window, dilation) in enumerate(DIL_PATTERNS):
        o, l = dilated_window_attention(q[:, :, g], k[:, :, g], v[:, :, g], dilation, window // dilation)
        outs.append(o)
        lses.append(l)
    wts = jax.nn.softmax(jnp.stack(lses, axis=0), axis=0)
    o = jnp.sum(wts[..., None] * jnp.stack(outs, axis=0), axis=0)
    y_b = o.reshape(bsz, s, DIL_OUT).astype(h.dtype) @ b_w_out
    gb, gc, hc = z[..., OFF_CB:OFF_CC], z[..., OFF_CC:OFF_CH], z[..., OFF_CH:OFF_G]
    y_c = (gb * causal_depthwise_conv(gc * hc, c_conv_w)) @ c_w_out
    gates = jax.nn.sigmoid(z[..., OFF_G:].reshape(bsz, s, N_BRANCH, D_MODEL))
    merged = gates[..., 0, :] * y_a + gates[..., 1, :] * y_b + gates[..., 2, :] * y_c
    return merged @ w_o


def memory_cross_attention(h, mem_n, wq, wk, wv, wo):
    bsz, s, _ = h.shape
    q = (h @ wq).reshape(bsz, s, XATTN_HEADS, XATTN_HEAD_DIM).astype(jnp.float32)
    k = (mem_n @ wk).reshape(bsz, -1, XATTN_HEADS, XATTN_HEAD_DIM).astype(jnp.float32)
    v = (mem_n @ wv).reshape(bsz, -1, XATTN_HEADS, XATTN_HEAD_DIM).astype(jnp.float32)
    p = jax.nn.softmax(jnp.einsum('bshe,bmhe->bhsm', q, k) * (XATTN_HEAD_DIM ** -0.5), axis=-1)
    o = jnp.einsum('bhsm,bmhe->bshe', p, v).reshape(bsz, s, D_MODEL).astype(h.dtype)
    return o @ wo


def swiglu(h, w1, w3, w2):
    return (jax.nn.silu(h @ w1) * (h @ w3)) @ w2


def moe_swiglu(h, w_router, w1, w3, w2):
    logits = (h @ w_router).astype(jnp.float32)
    top_val, top_idx = lax.top_k(logits, TOP_K)
    top_w = jax.nn.softmax(top_val, axis=-1)
    combine = jnp.sum(jax.nn.one_hot(top_idx, N_EXPERTS, dtype=jnp.float32) * top_w[..., None], axis=-2)
    out = jnp.zeros_like(h)
    for e in range(N_EXPERTS):
        out = out + combine[..., e:e + 1].astype(h.dtype) * swiglu(h, w1[e], w3[e], w2[e])
    return out


def setup_inputs(seed: int = 0) -> dict:
    key = jax.random.key(seed)
    ks = iter(jax.random.split(key, 40))

    def nrm(shape, scale):
        return jax.random.normal(next(ks), shape, jnp.float32) * scale

    def gain(shape):
        return 1.0 + nrm(shape, 0.02)

    L = DEPTH
    return {
        "x": nrm((BATCH, SEQ, D_MODEL), 1.0),
        "mem": nrm((BATCH, MEM_LEN, D_MODEL), 1.0),
        "norm_mix_g": gain((L, D_MODEL)),
        "w_in": nrm((L, D_MODEL, N_IN), D_MODEL ** -0.5),
        "b_in": nrm((L, N_IN), 0.02),
        "a_conv_w": nrm((L, CONV_A_KERNEL, CONV_A_WIDTH), CONV_A_KERNEL ** -0.5),
        "a_conv_b": nrm((L, CONV_A_WIDTH), 0.02),
        "a_ln_g": gain((L, CONV_A_WIDTH)),
        "a_ln_b": nrm((L, CONV_A_WIDTH), 0.02),
        "a_w_out": nrm((L, CONV_A_WIDTH, D_MODEL), CONV_A_WIDTH ** -0.5),
        "b_w_out": nrm((L, DIL_OUT, D_MODEL), DIL_OUT ** -0.5),
        "c_conv_w": nrm((L, SC_KERNEL, SC_WIDTH), SC_KERNEL ** -0.5),
        "c_w_out": nrm((L, SC_WIDTH, D_MODEL), SC_WIDTH ** -0.5),
        "w_o": nrm((L, D_MODEL, D_MODEL), D_MODEL ** -0.5),
        "norm_x_g": gain((L, D_MODEL)),
        "norm_mem_g": gain((L, D_MODEL)),
        "xq_w": nrm((L, D_MODEL, D_MODEL), D_MODEL ** -0.5),
        "xk_w": nrm((L, D_MODEL, D_MODEL), D_MODEL ** -0.5),
        "xv_w": nrm((L, D_MODEL, D_MODEL), D_MODEL ** -0.5),
        "xo_w": nrm((L, D_MODEL, D_MODEL), D_MODEL ** -0.5),
        "norm_ffn_g": gain((L, D_MODEL)),
        "ffn_w1": nrm((N_DENSE, D_MODEL, D_FF), D_MODEL ** -0.5),
        "ffn_w3": nrm((N_DENSE, D_MODEL, D_FF), D_MODEL ** -0.5),
        "ffn_w2": nrm((N_DENSE, D_FF, D_MODEL), D_FF ** -0.5),
        "moe_router": nrm((N_MOE, D_MODEL, N_EXPERTS), D_MODEL ** -0.5),
        "moe_w1": nrm((N_MOE, N_EXPERTS, D_MODEL, MOE_FF), D_MODEL ** -0.5),
        "moe_w3": nrm((N_MOE, N_EXPERTS, D_MODEL, MOE_FF), D_MODEL ** -0.5),
        "moe_w2": nrm((N_MOE, N_EXPERTS, MOE_FF, D_MODEL), MOE_FF ** -0.5),
        "final_g": gain((D_MODEL,)),
    }


def reference(x, mem, norm_mix_g, w_in, b_in, a_conv_w, a_conv_b, a_ln_g, a_ln_b, a_w_out,
              b_w_out, c_conv_w, c_w_out, w_o, norm_x_g, norm_mem_g, xq_w, xk_w, xv_w, xo_w,
              norm_ffn_g, ffn_w1, ffn_w3, ffn_w2, moe_router, moe_w1, moe_w3, moe_w2, final_g):
    for layer in range(DEPTH):
        h = rms_norm(x, norm_mix_g[layer])
        x = x + hybrid_mixer(h, w_in[layer], b_in[layer], a_conv_w[layer], a_conv_b[layer],
                             a_ln_g[layer], a_ln_b[layer], a_w_out[layer], b_w_out[layer],
                             c_conv_w[layer], c_w_out[layer], w_o[layer])
        h = rms_norm(x, norm_x_g[layer])
        mem_n = rms_norm(mem, norm_mem_g[layer])
        x = x + memory_cross_attention(h, mem_n, xq_w[layer], xk_w[layer], xv_w[layer], xo_w[layer])
        h = rms_norm(x, norm_ffn_g[layer])
        if layer % 2 == 0:
            i = layer // 2
            x = x + swiglu(h, ffn_w1[i], ffn_w3[i], ffn_w2[i])
        else:
            i = layer // 2
            x = x + moe_swiglu(h, moe_router[i], moe_w1[i], moe_w3[i], moe_w2[i])
    return rms_norm(x, final_g)
```

```cpp
#include <hip/hip_runtime.h>
#include <cstdio>
#include <cstdint>

#ifndef MK_DEBUG
#define MK_DEBUG 0
#endif
#ifndef MK_ONE_LAUNCH
#define MK_ONE_LAUNCH 1
#endif

#define GAS __attribute__((address_space(1)))
#define LAS __attribute__((address_space(3)))
typedef unsigned short bf16;
typedef short bf16x8 __attribute__((ext_vector_type(8)));
typedef short s16x4 __attribute__((ext_vector_type(4)));
typedef float f32x4 __attribute__((ext_vector_type(4)));
typedef float f32x2 __attribute__((ext_vector_type(2)));
typedef unsigned u32x4 __attribute__((ext_vector_type(4)));
typedef unsigned u32x2 __attribute__((ext_vector_type(2)));
typedef GAS unsigned gu32;

constexpr int D = 1024, NB = 2, SEQ = 16384, M = NB * SEQ, MEM = 256;
constexpr int NIN = 7936, OFF_A = 0, OFF_Q = 1024, OFF_K = 1792, OFF_V = 2560, OFF_CB = 3328, OFF_CC = 3840, OFF_CH = 4352, OFF_G = 4864;
constexpr int CA = 512, CAK = 31, DW = 768, DO = 256, CS = 512, KCAT = 1280;
constexpr int DFF = 2816, NE = 8, MFF = 3584;
constexpr float EPS = 1e-6f, LOG2E = 1.4426950408889634f;
constexpr float C2 = 0.125f * LOG2E;
constexpr float CX = 0.0625f * LOG2E;
constexpr int NWAVES = 8, NTHR = 512;
constexpr int MAXRT = 136;
constexpr int MOE_ROWS = MAXRT * 256;

constexpr size_t MiB = 1u << 20;
constexpr size_t WS_CTL = 0, CTL_ZERO_BYTES = 2 * MiB;
constexpr size_t WS_WQK = 2 * MiB;
constexpr size_t WS_WVO = 10 * MiB;
constexpr size_t WS_LSE = 18 * MiB;
constexpr size_t WS_RT = 20 * MiB;
constexpr size_t WS_BZ = 22 * MiB;
constexpr size_t WS_DBG = 23 * MiB;
constexpr size_t WS_SS = 28 * MiB;
constexpr int SSW = 16;
constexpr size_t WS_W = 40 * MiB;
constexpr size_t W_LAYER = 20 * MiB;
constexpr size_t W_WIN = 0, W_WCAT = 15872 * 1024, W_WO = W_WCAT + 2560 * 1024;
constexpr size_t WS_WFF = WS_W + 2 * W_LAYER;
constexpr size_t WFF_W13 = 0, WFF_W2 = 11 * MiB;
constexpr size_t WS_XB = WS_WFF + 17 * MiB;
constexpr size_t WS_R1 = WS_XB + 64 * MiB;
constexpr size_t R_AG = 0, R_GB = 32 * MiB, R_CP = 64 * MiB, R_Q = 96 * MiB, R_K = 144 * MiB, R_V = 192 * MiB, R_G = 240 * MiB;
constexpr size_t R_ACT = R_K;
constexpr size_t R_MRG = 0;
constexpr size_t R_P = 0;
constexpr size_t R_U = 0;
constexpr size_t R_MW13 = 240 * MiB, R_MW2 = 352 * MiB;
constexpr size_t R_MN = 0, R_KM = 2 * MiB, R_VM = 4 * MiB, R_WQ = 6 * MiB, R_WKV = 10 * MiB, R_WOT = 18 * MiB;
constexpr size_t WS_END = WS_R1 + 432 * MiB;
static_assert(R_MW2 + 56 * MiB <= 432 * MiB && (size_t)MOE_ROWS * MFF * 2 <= R_MW13, "R1 map");
constexpr size_t RT_E = 0;
constexpr size_t RT_W = 128 * 1024;
constexpr size_t RT_RS = 384 * 1024;
constexpr size_t RT_POS = 512 * 1024;
constexpr size_t RT_BB = 768 * 1024;
constexpr size_t RT_LIST = 800 * 1024;
constexpr size_t RT_LW = RT_LIST + 2 * MOE_ROWS * 4;
constexpr size_t RT_LR = RT_LW + 2 * MOE_ROWS * 4;
static_assert(RT_LR + 2 * MOE_ROWS * 4 <= 2 * MiB, "routing tables");
constexpr int CW_TMO = 0, CW_BAR = 4096, CW_CNT = 8192  , CW_CHK = 12288;

#define RLX_AGENT __ATOMIC_RELAXED, __HIP_MEMORY_SCOPE_AGENT
#define LDS_WAIT() asm volatile("s_waitcnt lgkmcnt(0)" ::: "memory")
#define VM_WAIT() asm volatile("s_waitcnt vmcnt(0)" ::: "memory")
__device__ __forceinline__ unsigned f2bf(float f) { unsigned u = __builtin_bit_cast(unsigned, f); return (u + 0x7fffu + ((u >> 16) & 1u)) >> 16; }
__device__ __forceinline__ unsigned pk2(float lo, float hi) { return f2bf(lo) | (f2bf(hi) << 16); }
typedef __bf16 bf16x2_t __attribute__((ext_vector_type(2)));
__device__ __forceinline__ unsigned cvt_pk_bf16(float lo, float hi) { const f32x2 v = {lo, hi}; const bf16x2_t b = __builtin_convertvector(v, bf16x2_t); return __builtin_bit_cast(unsigned, b); }
__device__ __forceinline__ float bflo(unsigned u) { return __builtin_bit_cast(float, u << 16); }
__device__ __forceinline__ float bfhi(unsigned u) { return __builtin_bit_cast(float, u & 0xffff0000u); }
__device__ __forceinline__ float bf2f(bf16 b) { return __builtin_bit_cast(float, (unsigned)b << 16); }
__device__ __forceinline__ float fexp2(float x) { return __builtin_amdgcn_exp2f(x); }
__device__ __forceinline__ float frcp(float x) { return __builtin_amdgcn_rcpf(x); }
__device__ __forceinline__ float sigmoidf_(float x) { return frcp(1.f + fexp2(-LOG2E * x)); }
__device__ __forceinline__ float wave_sum(float v) {
#pragma unroll
    for (int o = 1; o < 64; o <<= 1) v += __shfl_xor(v, o);
    return v;
}
__device__ __forceinline__ float row_rstd(const float* ss, int row) {
    const f32x4* p = (const f32x4*)(ss + (size_t)row * SSW); const f32x4 a = p[0], b = p[1], c = p[2], d = p[3];
    const float t = (((a[0] + a[1]) + (a[2] + a[3])) + ((b[0] + b[1]) + (b[2] + b[3]))) + (((c[0] + c[1]) + (c[2] + c[3])) + ((d[0] + d[1]) + (d[2] + d[3])));
    return __builtin_amdgcn_rsqf(t * (1.f / D) + EPS);
}
__device__ __forceinline__ u32x4 pack8(const f32x4& a, const f32x4& b) { u32x4 w; w.x = cvt_pk_bf16(a[0], a[1]); w.y = cvt_pk_bf16(a[2], a[3]); w.z = cvt_pk_bf16(b[0], b[1]); w.w = cvt_pk_bf16(b[2], b[3]); return w; }
__device__ __forceinline__ void unpack8(const u32x4& w, f32x4& a, f32x4& b) { a = (f32x4){bflo(w.x), bfhi(w.x), bflo(w.y), bfhi(w.y)}; b = (f32x4){bflo(w.z), bfhi(w.z), bflo(w.w), bfhi(w.w)}; }

#define XB_TMO      128
#define XB_XCNT(j)  (256  + 64 * (j))
#define XB_XSUB(j)  (1280 + 64 * (j))
#define XB_XGEN(j)  (2304 + 64 * (j))
#define XB_TOP      3328
#define XB_TOPGEN   3392
#define XCD_BAR_WORDS 3456
#define XB_SPIN_CAP (1u << 18)
__device__ __forceinline__ unsigned xb_ld(unsigned* p)              { return __hip_atomic_load(p, __ATOMIC_RELAXED, __HIP_MEMORY_SCOPE_AGENT); }
__device__ __forceinline__ unsigned xb_add(unsigned* p, unsigned v) { return __hip_atomic_fetch_add(p, v, __ATOMIC_RELAXED, __HIP_MEMORY_SCOPE_AGENT); }
__device__ __forceinline__ unsigned xb_xcc_id() { return (unsigned)__builtin_amdgcn_s_getreg((3 << 11) | 20) & 0xFu; }
#define XB_SPIN(cond, bar) do { unsigned _sp = 0; while (cond) { __builtin_amdgcn_s_sleep(1); \
    if ((++_sp & 255u) == 0u) { if (xb_ld(&(bar)[XB_TMO])) break; if (_sp > XB_SPIN_CAP) { atomicAdd(&(bar)[XB_TMO], 1u); break; } } } } while (0)
struct XcdBarrier { unsigned* bar; unsigned x; volatile LAS unsigned* st; };
__device__ __forceinline__ XcdBarrier xcd_barrier_post(unsigned* bar, volatile LAS unsigned* st) {
    XcdBarrier b; b.bar = bar; b.x = xb_xcc_id(); b.st = st;
    if (threadIdx.x == 0) (void)xb_add(&bar[XB_XCNT(b.x)], 1u);
    return b;
}
__device__ __forceinline__ void xcd_barrier_complete(unsigned* bar, unsigned x, unsigned& nloc, unsigned& nx) {
    const unsigned G = gridDim.x * gridDim.y * gridDim.z;
    unsigned sum, cnt, mine, sp = 0u;
    for (;;) {
        sum = 0u; cnt = 0u; mine = 0u;
#pragma unroll
        for (unsigned j = 0; j < 16; ++j) { const unsigned c = xb_ld(&bar[XB_XCNT(j)]); sum += c; cnt += (c > 0u) ? 1u : 0u; mine = (j == x) ? c : mine; }
        if (sum == G) break;
        __builtin_amdgcn_s_sleep(1);
        if ((++sp & 255u) == 0u) { if (xb_ld(&bar[XB_TMO])) break; if (sp > XB_SPIN_CAP) { atomicAdd(&bar[XB_TMO], 1u); break; } }
    }
    nloc = mine > 0u ? mine : 1u; nx = cnt > 0u ? cnt : 1u;
}
__device__ __forceinline__ void xcd_barrier(const XcdBarrier& b) {
    asm volatile("s_waitcnt vmcnt(0)" ::: "memory");
    __syncthreads();
    if (threadIdx.x == 0) {
        unsigned* bar = b.bar;
        __builtin_amdgcn_s_waitcnt(0);
        unsigned nloc = b.st[0], nx = b.st[1];
        if (nloc == 0u) { xcd_barrier_complete(bar, b.x, nloc, nx); b.st[0] = nloc; b.st[1] = nx; }
        const unsigned old = xb_add(&bar[XB_XSUB(b.x)], 1u);
        const unsigned gen = old / nloc;
        if (old + 1u == (gen + 1u) * nloc) {
            __builtin_amdgcn_fence(__ATOMIC_RELEASE, "agent");
            asm volatile("s_waitcnt vmcnt(0)" ::: "memory");
            const unsigned og = xb_add(&bar[XB_TOP], 1u);
            const unsigned tg = og / nx;
            if (og + 1u == (tg + 1u) * nx) xb_add(&bar[XB_TOPGEN], 1u);
            else XB_SPIN(xb_ld(&bar[XB_TOPGEN]) == tg, bar);
            __builtin_amdgcn_fence(__ATOMIC_ACQUIRE, "agent");
            xb_add(&bar[XB_XGEN(b.x)], 1u);
            asm volatile("s_waitcnt vmcnt(0)" ::: "memory");
        } else {
            XB_SPIN(xb_ld(&bar[XB_XGEN(b.x)]) == gen, bar);
            __builtin_amdgcn_fence(__ATOMIC_ACQUIRE, "agent");
            asm volatile("s_waitcnt vmcnt(0)" ::: "memory");
        }
    }
    __syncthreads();
}

namespace pg8 {
constexpr int BM = 256, BK = 64, HALF = 128, HTB = HALF * BK * 2, STAGE_BYTES = 8 * HTB, NXCD = 8, WGM = 8;
__host__ __device__ __forceinline__ int lds_byte(int r, int c) { const int st = (r >> 4) * 2 + (c >> 5), rr = r & 15, cc = c & 31, ob = rr * 64 + cc * 2; return st * 1024 + (ob ^ (((ob >> 9) & 1) << 5)); }
__host__ __device__ __forceinline__ void stage_rc(int b, int& R, int& C) { const int st = b / 1024, sb = b % 1024, swz = sb ^ (((sb >> 9) & 1) << 5); R = (st >> 1) * 16 + swz / 64; C = (st & 1) * 32 + (swz % 64) / 2; }
__host__ __device__ __forceinline__ int perm32(int rho) { const int n = rho >> 4, i = rho & 15; return 8 * (i >> 2) + 4 * n + (i & 3); }
struct Unit { int pm, pn; };
typedef f32x4 Acc[2][2][4][2];

struct Order {
    int nM, nN, nwg, G, c;
    __device__ __forceinline__ void init(int nM_, int nN_, int G_, int c_) { nM = nM_; nN = nN_; nwg = nM * nN; G = G_; c = c_; }
    __device__ __forceinline__ bool next(int i, Unit& u) const {
        const long L = (long)i * G + c; if (L >= nwg) return false;
        int wgid = (int)L; { const int q = nwg / NXCD, r = nwg % NXCD, xcd = wgid % NXCD, off = wgid / NXCD; wgid = (xcd < r ? xcd * (q + 1) : r * (q + 1) + (xcd - r) * q) + off; }
        const int nig = WGM * nN, gid = wgid / nig, fm = gid * WGM, gsz = (nM - fm) < WGM ? (nM - fm) : WGM;
        u.pm = fm + ((wgid % nig) % gsz); u.pn = (wgid % nig) / gsz; return true;
    }
};

template <class P, bool ALIGN_EPI>
__device__ __forceinline__ void gemm_phase(LAS unsigned char* lds, const P& p) {
    int tid = threadIdx.x; asm volatile("" : "+v"(tid));
    const int wid = __builtin_amdgcn_readfirstlane(tid >> 6), lane = tid & 63, wr = wid >> 2, wc = wid & 3, fr = lane & 15, fq = lane >> 4;
    const int nt = p.nt();
    const unsigned lda = (unsigned)p.lda(), ldb = (unsigned)p.ldb();
    int RA[2]; unsigned CA2[2], voffA[2], voffB[2];
#pragma unroll
    for (int i = 0; i < 2; ++i) { int R, C; stage_rc(tid * 16 + i * 8192, R, C); RA[i] = R; CA2[i] = (unsigned)C * 2u; voffA[i] = (unsigned)R * lda + (unsigned)C * 2u; const int Rb = (R & ~31) + perm32(R & 31); voffB[i] = (unsigned)Rb * ldb + (unsigned)C * 2u; }
    const size_t hA = P::GATHER ? (size_t)0 : (size_t)HALF * lda;
    const size_t kstep = (size_t)(BK * 2);
    const size_t hB = (size_t)HALF * ldb;
    const unsigned ldsw = (unsigned)wid * 1024u;
    const int aoff = lds_byte(wr * 64 + fr, fq * 8), boff = lds_byte(wc * 32 + fr, fq * 8);
#define PG8_SA(b, h) (((b) * 2 + (h)) * HTB)
#define PG8_SB(b, h) ((4 + (b) * 2 + (h)) * HTB)
#define PG8_STAGE_A(bufoff, gbase, off2) do { _Pragma("unroll") for (int _i = 0; _i < 2; ++_i) \
        __builtin_amdgcn_global_load_lds((const unsigned*)((const char*)(gbase) + (off2)[_i]), (LAS unsigned*)(lds + (bufoff) + ldsw + _i * 8192), 16, 0, 0); } while (0)
#define PG8_STAGE_B(bufoff, gbase) do { _Pragma("unroll") for (int _i = 0; _i < 2; ++_i) \
        __builtin_amdgcn_global_load_lds((const unsigned*)((const char*)(gbase) + voffB[_i]), (LAS unsigned*)(lds + (bufoff) + ldsw + _i * 8192), 16, 0, 0); } while (0)
#define PG8_LDA(dst, b, h) do { _Pragma("unroll") for (int m = 0; m < 4; ++m) _Pragma("unroll") for (int k = 0; k < 2; ++k) dst[m][k] = *(const LAS bf16x8*)(lds + PG8_SA(b, h) + aoff + m * 2048 + k * 1024); } while (0)
#define PG8_LDB(dst, b, h) do { _Pragma("unroll") for (int n = 0; n < 2; ++n) _Pragma("unroll") for (int k = 0; k < 2; ++k) dst[n][k] = *(const LAS bf16x8*)(lds + PG8_SB(b, h) + boff + n * 2048 + k * 1024); } while (0)
#define PG8_MMA(ai, bj, At, Bt) do { __builtin_amdgcn_s_setprio(1); _Pragma("unroll") for (int m = 0; m < 4; ++m) _Pragma("unroll") for (int n = 0; n < 2; ++n) _Pragma("unroll") for (int k = 0; k < 2; ++k) \
        acc[ai][bj][m][n] = __builtin_amdgcn_mfma_f32_16x16x32_bf16(Bt[n][k], At[m][k], acc[ai][bj][m][n], 0, 0, 0); __builtin_amdgcn_s_setprio(0); } while (0)
#define PG8_WAIT_V(n) asm volatile("s_waitcnt vmcnt(" #n ")" ::: "memory")
#define PG8_WAIT_L(n) asm volatile("s_waitcnt lgkmcnt(" #n ")" ::: "memory")
#define PG8_BAR __builtin_amdgcn_s_barrier()
#define PG8_SCHED __builtin_amdgcn_sched_barrier(0)
#define PG8_OFFS(u, O) do { _Pragma("unroll") for (int _h = 0; _h < 2; ++_h) _Pragma("unroll") for (int _i = 0; _i < 2; ++_i) \
        O[_h][_i] = P::GATHER ? (p.a_row(u, _h * HALF + RA[_i]) + CA2[_i]) : voffA[_i]; } while (0)
    Unit cur, nxt; int ui = 0;
    if (!p.next(0, cur)) return;
    Acc acc;
#pragma unroll
    for (int a = 0; a < 2; ++a)
#pragma unroll
        for (int b = 0; b < 2; ++b)
#pragma unroll
            for (int m = 0; m < 4; ++m)
#pragma unroll
                for (int n = 0; n < 2; ++n) acc[a][b][m][n] = (f32x4){0.f, 0.f, 0.f, 0.f};
    bf16x8 At[4][2], B0[2][2], B1[2][2];
    const char* cA = p.a_base(cur); const char* cB = p.b_base(cur);
    unsigned cO[2][2], nO[2][2];
    PG8_OFFS(cur, cO);
    PG8_STAGE_B(PG8_SB(0, 0), cB); PG8_STAGE_B(PG8_SB(0, 1), cB + hB); PG8_STAGE_A(PG8_SA(0, 0), cA, cO[0]); PG8_STAGE_A(PG8_SA(0, 1), cA + hA, cO[1]);
    if (wr == 1) PG8_BAR;
    PG8_WAIT_V(2); PG8_BAR;
    PG8_STAGE_B(PG8_SB(1, 0), cB + kstep); PG8_STAGE_A(PG8_SA(1, 0), cA + kstep, cO[0]); PG8_STAGE_B(PG8_SB(1, 1), cB + hB + kstep);
    PG8_WAIT_V(6); PG8_BAR;
    for (;;) {
        const bool has_next = p.next(ui + 1, nxt);
        const char* nA = has_next ? p.a_base(nxt) : cA; const char* nB = has_next ? p.b_base(nxt) : cB;
        if (P::GATHER) { if (has_next) { PG8_OFFS(nxt, nO); } else {
#pragma unroll
            for (int h = 0; h < 2; ++h)
#pragma unroll
                for (int i = 0; i < 2; ++i) nO[h][i] = cO[h][i]; } }
        for (int t = 0; t < nt; t += 2) {
            if constexpr (P::HOOK) { if (p.is_hook(t)) p.hook(acc, cur, t, wr, wc, fr, fq); }
            const bool last = (t == nt - 2);
            const char* a1 = cA + (size_t)(t + 1) * kstep;
            const char* a2 = last ? nA : cA + (size_t)(t + 2) * kstep; const char* b2 = last ? nB : cB + (size_t)(t + 2) * kstep;
            const char* a3 = a2 + kstep; const char* b3 = b2 + kstep;
            unsigned o2[2][2];
#pragma unroll
            for (int h = 0; h < 2; ++h)
#pragma unroll
                for (int i = 0; i < 2; ++i) o2[h][i] = (P::GATHER && last) ? nO[h][i] : cO[h][i];
            PG8_LDB(B0, 0, 0); PG8_LDB(B1, 0, 1); PG8_SCHED; PG8_LDA(At, 0, 0); PG8_STAGE_A(PG8_SA(1, 1), a1 + hA, cO[1]);
            PG8_WAIT_V(8); PG8_WAIT_L(0); PG8_BAR; PG8_MMA(0, 0, At, B0); PG8_MMA(0, 1, At, B1); PG8_BAR; PG8_SCHED;
            PG8_LDA(At, 0, 1); PG8_STAGE_B(PG8_SB(0, 0), b2); PG8_STAGE_B(PG8_SB(0, 1), b2 + hB); PG8_STAGE_A(PG8_SA(0, 0), a2, o2[0]);
            PG8_WAIT_V(8); PG8_WAIT_L(0); PG8_BAR; PG8_MMA(1, 0, At, B0); PG8_MMA(1, 1, At, B1); PG8_BAR; PG8_SCHED;
            PG8_LDB(B0, 1, 0); PG8_LDB(B1, 1, 1); PG8_SCHED; PG8_LDA(At, 1, 0); PG8_STAGE_A(PG8_SA(0, 1), a2 + hA, o2[1]);
            PG8_WAIT_V(8); PG8_WAIT_L(0); PG8_BAR; PG8_MMA(0, 0, At, B0); PG8_MMA(0, 1, At, B1); PG8_BAR; PG8_SCHED;
            PG8_LDA(At, 1, 1); PG8_STAGE_B(PG8_SB(1, 0), b3); PG8_STAGE_B(PG8_SB(1, 1), b3 + hB); PG8_STAGE_A(PG8_SA(1, 0), a3, o2[0]);
            PG8_WAIT_V(8); PG8_WAIT_L(0); PG8_BAR; PG8_MMA(1, 0, At, B0); PG8_MMA(1, 1, At, B1); PG8_BAR; PG8_SCHED;
        }
        if constexpr (ALIGN_EPI) { if (wr == 0) PG8_BAR; }
        p.epi(acc, cur, wr, wc, fr, fq);
        if (!has_next) break;
#pragma unroll
        for (int a = 0; a < 2; ++a)
#pragma unroll
            for (int b = 0; b < 2; ++b)
#pragma unroll
                for (int m = 0; m < 4; ++m)
#pragma unroll
                    for (int n = 0; n < 2; ++n) acc[a][b][m][n] = (f32x4){0.f, 0.f, 0.f, 0.f};
        cur = nxt; cA = nA; cB = nB; ++ui;
        if (P::GATHER) {
#pragma unroll
            for (int h = 0; h < 2; ++h)
#pragma unroll
                for (int i = 0; i < 2; ++i) cO[h][i] = nO[h][i]; }
        if constexpr (ALIGN_EPI) { if (wr == 1) PG8_BAR; }
    }
    PG8_WAIT_V(0);
    if constexpr (!ALIGN_EPI) { if (wr == 0) PG8_BAR; }
    PG8_BAR;
#undef PG8_SA
#undef PG8_SB
#undef PG8_STAGE_A
#undef PG8_STAGE_B
#undef PG8_LDA
#undef PG8_LDB
#undef PG8_MMA
#undef PG8_WAIT_V
#undef PG8_WAIT_L
#undef PG8_BAR
#undef PG8_SCHED
#undef PG8_OFFS
}
}
namespace pol {
using pg8::Unit; using pg8::Acc; using pg8::Order;
#define EPI_ROWS(u) const int row0 = (u).pm * 256 + wr * 64 + fr; const int cl = wc * 32 + 8 * fq;
#define FOR_AI_M _Pragma("unroll") for (int ai = 0; ai < 2; ++ai) _Pragma("unroll") for (int m = 0; m < 4; ++m)

struct PolPlain : Order {
    static constexpr bool HOOK = false, GATHER = false;
    const char* A; const char* Bt; char* C; int lda_, ldb_, ldc_, nt_;
    int mper, n0, n1; size_t a0, a1, a2, b0, b1, b2, c0, c1, c2;
    __device__ __forceinline__ int nt() const { return nt_; }
    __device__ __forceinline__ int lda() const { return lda_; }
    __device__ __forceinline__ int ldb() const { return ldb_; }
    __device__ __forceinline__ void dec(const Unit& u, int& j0, int& j1, int& j2, int& r) const { const int j = u.pm / mper; r = u.pm % mper; j0 = j % n0; j1 = (j / n0) % n1; j2 = j / (n0 * n1); }
    __device__ __forceinline__ const char* a_base(const Unit& u) const { int j0, j1, j2, r; dec(u, j0, j1, j2, r); return A + j0 * a0 + j1 * a1 + j2 * a2 + (size_t)r * 256 * lda_; }
    __device__ __forceinline__ const char* b_base(const Unit& u) const { int j0, j1, j2, r; dec(u, j0, j1, j2, r); return Bt + j0 * b0 + j1 * b1 + j2 * b2 + (size_t)u.pn * 256 * ldb_; }
    __device__ __forceinline__ unsigned a_row(const Unit&, int) const { return 0u; }
    __device__ __forceinline__ bool is_hook(int) const { return false; }
    __device__ __forceinline__ void hook(Acc&, const Unit&, int, int, int, int, int) const {}
    __device__ __forceinline__ void epi(const Acc& acc, const Unit& u, int wr, int wc, int fr, int fq) const {
        int j0, j1, j2, r; dec(u, j0, j1, j2, r); const int cl = wc * 32 + 8 * fq;
        char* cb = C + j0 * c0 + j1 * c1 + j2 * c2 + (size_t)(r * 256 + wr * 64 + fr) * ldc_ + (size_t)(u.pn * 256 + cl) * 2;
        FOR_AI_M { char* rp = cb + (size_t)(ai * 128 + m * 16) * ldc_;
#pragma unroll
            for (int bj = 0; bj < 2; ++bj) *(u32x4*)(rp + bj * 256) = pack8(acc[ai][bj][m][0], acc[ai][bj][m][1]); }
    }
};

struct PolZ : Order {
    static constexpr bool HOOK = false, GATHER = false;
    const char* A; const char* Bt; const float* ss; const float* bz;
    unsigned char* R1;
    __device__ __forceinline__ int nt() const { return 16; }
    __device__ __forceinline__ int lda() const { return 2048; }
    __device__ __forceinline__ int ldb() const { return 2048; }
    __device__ __forceinline__ const char* a_base(const Unit& u) const { return A + (size_t)u.pm * 256 * 2048; }
    __device__ __forceinline__ const char* b_base(const Unit& u) const { return Bt + (size_t)u.pn * 256 * 2048; }
    __device__ __forceinline__ unsigned a_row(const Unit&, int) const { return 0u; }
    __device__ __forceinline__ bool is_hook(int) const { return false; }
    __device__ __forceinline__ void hook(Acc&, const Unit&, int, int, int, int, int) const {}
    __device__ __forceinline__ void epi(const Acc& acc, const Unit& u, int wr, int wc, int fr, int fq) const {
        EPI_ROWS(u); const int pn = u.pn;
        unsigned char* r1 = R1; asm volatile("" : "+s"(r1));
        bf16 *AG = (bf16*)(r1 + R_AG), *Q = (bf16*)(r1 + R_Q), *K = (bf16*)(r1 + R_K), *V = (bf16*)(r1 + R_V), *GB = (bf16*)(r1 + R_GB), *CP = (bf16*)(r1 + R_CP), *Gt = (bf16*)(r1 + R_G);
        f32x4 bv[2][2];
#pragma unroll
        for (int bj = 0; bj < 2; ++bj)
#pragma unroll
            for (int n = 0; n < 2; ++n) bv[bj][n] = *(const f32x4*)(bz + pn * 256 + bj * 128 + cl + 4 * n);
        FOR_AI_M { const int row = row0 + ai * 128 + m * 16; const float rs = row_rstd(ss, row);
            f32x4 z[2][2];
#pragma unroll
            for (int bj = 0; bj < 2; ++bj)
#pragma unroll
                for (int n = 0; n < 2; ++n) z[bj][n] = acc[ai][bj][m][n] * rs + bv[bj][n];
            if (pn < 4) {
                f32x4 o[2];
#pragma unroll
                for (int n = 0; n < 2; ++n)
#pragma unroll
                    for (int j = 0; j < 4; ++j) o[n][j] = z[0][n][j] * sigmoidf_(z[1][n][j]);
                *(u32x4*)(AG + (size_t)row * CA + pn * 128 + cl) = pack8(o[0], o[1]);
            } else if (pn < 13) {
                const int t = pn - 4, which = t / 3, g = t % 3; bf16* base = which == 0 ? Q : (which == 1 ? K : V); const float sc = which == 0 ? C2 : 1.f;
#pragma unroll
                for (int bj = 0; bj < 2; ++bj) *(u32x4*)(base + (size_t)row * DW + g * 256 + bj * 128 + cl) = pack8(z[bj][0] * sc, z[bj][1] * sc);
            } else if (pn < 15) {
#pragma unroll
                for (int bj = 0; bj < 2; ++bj) *(u32x4*)(GB + (size_t)row * CS + (pn - 13) * 256 + bj * 128 + cl) = pack8(z[bj][0], z[bj][1]);
            } else if (pn < 19) {
                *(u32x4*)(CP + (size_t)row * CS + (pn - 15) * 128 + cl) = pack8(z[0][0] * z[1][0], z[0][1] * z[1][1]);
            } else {
#pragma unroll
                for (int bj = 0; bj < 2; ++bj) { f32x4 o[2];
#pragma unroll
                    for (int n = 0; n < 2; ++n)
#pragma unroll
                        for (int j = 0; j < 4; ++j) o[n][j] = sigmoidf_(z[bj][n][j]);
                    *(u32x4*)(Gt + (size_t)row * 3072 + (pn - 19) * 256 + bj * 128 + cl) = pack8(o[0], o[1]); }
            }
        }
    }
};

struct PolMerge : Order {
    static constexpr bool HOOK = true, GATHER = false;
    const char* A; const char* Bt; const bf16* Gt; bf16* MRG;
    __device__ __forceinline__ int nt() const { return KCAT / 64; }
    __device__ __forceinline__ int lda() const { return KCAT * 2; }
    __device__ __forceinline__ int ldb() const { return KCAT * 2; }
    __device__ __forceinline__ const char* a_base(const Unit& u) const { return A + (size_t)u.pm * 256 * KCAT * 2; }
    __device__ __forceinline__ const char* b_base(const Unit& u) const { return Bt + (size_t)u.pn * 256 * KCAT * 2; }
    __device__ __forceinline__ unsigned a_row(const Unit&, int) const { return 0u; }
    __device__ __forceinline__ bool is_hook(int t) const { return t == 8 || t == 12; }
    __device__ __forceinline__ void hook(Acc& acc, const Unit& u, int t, int wr, int wc, int fr, int fq) const {
        const int br = (t == 8) ? 0 : 1; const int cl = wc * 32 + 8 * fq;
        int row0 = u.pm * 256 + wr * 64 + fr; asm volatile("" : "+v"(row0));
#pragma unroll
        for (int ai = 0; ai < 2; ++ai)
#pragma unroll
            for (int bj = 0; bj < 2; ++bj) {
                u32x4 wa[4], wb[4];
#pragma unroll
                for (int m = 0; m < 4; ++m) { const bf16* gp = Gt + (size_t)(row0 + ai * 128 + m * 16) * 3072 + br * 1024 + u.pn * 256 + cl + bj * 128; wa[m] = *(const u32x4*)gp; wb[m] = *(const u32x4*)(gp + 1024); }
#pragma unroll
                for (int m = 0; m < 4; ++m) { f32x4 a0, a1, b0, b1; unpack8(wa[m], a0, a1); unpack8(wb[m], b0, b1);
#pragma unroll
                    for (int j = 0; j < 4; ++j) { acc[ai][bj][m][0][j] *= a0[j] * frcp(b0[j]); acc[ai][bj][m][1][j] *= a1[j] * frcp(b1[j]); }
                    asm volatile("" : "+v"(acc[ai][bj][m][0]), "+v"(acc[ai][bj][m][1]) :: "memory"); }
            }
    }
    __device__ __forceinline__ void epi(const Acc& acc, const Unit& u, int wr, int wc, int fr, int fq) const {
        EPI_ROWS(u);
        FOR_AI_M { const int row = row0 + ai * 128 + m * 16; const bf16* gp = Gt + (size_t)row * 3072 + 2048 + u.pn * 256 + cl;
#pragma unroll
            for (int bj = 0; bj < 2; ++bj) { const u32x4 wa = *(const u32x4*)(gp + bj * 128); f32x4 a0, a1; unpack8(wa, a0, a1);
                *(u32x4*)(MRG + (size_t)row * D + u.pn * 256 + bj * 128 + cl) = pack8(acc[ai][bj][m][0] * a0, acc[ai][bj][m][1] * a1); } }
    }
};

struct PolRes : Order {
    static constexpr bool HOOK = false, GATHER = false;
    const char* A; const char* Bt; size_t b_batch; int K; const float* xin; float* xout; bf16* XB; float* ssn;
    __device__ __forceinline__ int nt() const { return K / 64; }
    __device__ __forceinline__ int lda() const { return K * 2; }
    __device__ __forceinline__ int ldb() const { return K * 2; }
    __device__ __forceinline__ const char* a_base(const Unit& u) const { return A + (size_t)u.pm * 256 * K * 2; }
    __device__ __forceinline__ const char* b_base(const Unit& u) const { return Bt + (u.pm >= 64 ? b_batch : (size_t)0) + (size_t)u.pn * 256 * K * 2; }
    __device__ __forceinline__ unsigned a_row(const Unit&, int) const { return 0u; }
    __device__ __forceinline__ bool is_hook(int) const { return false; }
    __device__ __forceinline__ void hook(Acc&, const Unit&, int, int, int, int, int) const {}
    __device__ __forceinline__ void epi(const Acc& acc, const Unit& u, int wr, int wc, int fr, int fq) const {
        EPI_ROWS(u);
        FOR_AI_M { const int row = row0 + ai * 128 + m * 16; const size_t o = (size_t)row * D + u.pn * 256 + cl; float sq = 0.f;
#pragma unroll
            for (int bj = 0; bj < 2; ++bj) { f32x4 v0 = *(const f32x4*)(xin + o + bj * 128) + acc[ai][bj][m][0], v1 = *(const f32x4*)(xin + o + bj * 128 + 4) + acc[ai][bj][m][1];
                *(f32x4*)(xout + o + bj * 128) = v0; *(f32x4*)(xout + o + bj * 128 + 4) = v1;
                sq += (v0[0] * v0[0] + v0[1] * v0[1]) + (v0[2] * v0[2] + v0[3] * v0[3]) + (v1[0] * v1[0] + v1[1] * v1[1]) + (v1[2] * v1[2] + v1[3] * v1[3]);
                *(u32x4*)(XB + o + bj * 128) = pack8(v0, v1); }
            sq += __shfl_xor(sq, 16); sq += __shfl_xor(sq, 32);
            if (fq == 0) ssn[(size_t)row * SSW + u.pn * 4 + wc] = sq; }
    }
};

struct PolXS : Order {
    static constexpr bool HOOK = false, GATHER = false;
    const char* A; const char* Bt; size_t b_batch; const float* ss; bf16* P; LAS float* xch;
    mutable int parity;
    __device__ __forceinline__ int nt() const { return 16; }
    __device__ __forceinline__ int lda() const { return 2048; }
    __device__ __forceinline__ int ldb() const { return 2048; }
    __device__ __forceinline__ const char* a_base(const Unit& u) const { return A + (size_t)u.pm * 256 * 2048; }
    __device__ __forceinline__ const char* b_base(const Unit& u) const { return Bt + (u.pm >= 64 ? b_batch : (size_t)0) + (size_t)u.pn * 256 * 2048; }
    __device__ __forceinline__ unsigned a_row(const Unit&, int) const { return 0u; }
    __device__ __forceinline__ bool is_hook(int) const { return false; }
    __device__ __forceinline__ void hook(Acc&, const Unit&, int, int, int, int, int) const {}
    __device__ __forceinline__ void epi(const Acc& acc, const Unit& u, int wr, int wc, int fr, int fq) const {
        EPI_ROWS(u);
        LAS float* xb = xch + parity * 2048; parity ^= 1;
        float mw[2][4], lw[2][4];
        FOR_AI_M { const int row = row0 + ai * 128 + m * 16; const float rs = row_rstd(ss, row);
            float mx = -3.0e38f;
#pragma unroll
            for (int bj = 0; bj < 2; ++bj)
#pragma unroll
                for (int n = 0; n < 2; ++n)
#pragma unroll
                    for (int j = 0; j < 4; ++j) mx = fmaxf(mx, acc[ai][bj][m][n][j] * rs);
            mx = fmaxf(mx, __shfl_xor(mx, 16)); mx = fmaxf(mx, __shfl_xor(mx, 32));
            float sm = 0.f;
#pragma unroll
            for (int bj = 0; bj < 2; ++bj)
#pragma unroll
                for (int n = 0; n < 2; ++n)
#pragma unroll
                    for (int j = 0; j < 4; ++j) sm += fexp2(acc[ai][bj][m][n][j] * rs - mx);
            sm += __shfl_xor(sm, 16); sm += __shfl_xor(sm, 32);
            mw[ai][m] = mx; lw[ai][m] = sm;
            if (fq == 0) { const int rl = ai * 128 + wr * 64 + m * 16 + fr; *(LAS f32x2*)(xb + (rl * 4 + wc) * 2) = (f32x2){mx, sm}; } }
        asm volatile("s_waitcnt lgkmcnt(0)" ::: "memory"); __builtin_amdgcn_s_barrier(); asm volatile("" ::: "memory");
        FOR_AI_M { const int row = row0 + ai * 128 + m * 16; const float rs = row_rstd(ss, row);
            const int rl = ai * 128 + wr * 64 + m * 16 + fr;
            const f32x4 e0 = *(const LAS f32x4*)(xb + rl * 8), e1 = *(const LAS f32x4*)(xb + rl * 8 + 4);
            const float MX = fmaxf(fmaxf(e0[0], e0[2]), fmaxf(e1[0], e1[2]));
            const float L = e0[1] * fexp2(e0[0] - MX) + e0[3] * fexp2(e0[2] - MX) + e1[1] * fexp2(e1[0] - MX) + e1[3] * fexp2(e1[2] - MX);
            const float inv = frcp(L); const float off = MX;
#pragma unroll
            for (int bj = 0; bj < 2; ++bj) { f32x4 o[2];
#pragma unroll
                for (int n = 0; n < 2; ++n)
#pragma unroll
                    for (int j = 0; j < 4; ++j) o[n][j] = fexp2(acc[ai][bj][m][n][j] * rs - off) * inv;
                *(u32x4*)(P + (size_t)row * D + u.pn * 256 + bj * 128 + cl) = pack8(o[0], o[1]); } }
        (void)mw; (void)lw;
    }
};

struct PolUp : Order {
    static constexpr bool HOOK = false, GATHER = false;
    const char* A; const char* Bt; const float* ss; bf16* U;
    __device__ __forceinline__ int nt() const { return 16; }
    __device__ __forceinline__ int lda() const { return 2048; }
    __device__ __forceinline__ int ldb() const { return 2048; }
    __device__ __forceinline__ const char* a_base(const Unit& u) const { return A + (size_t)u.pm * 256 * 2048; }
    __device__ __forceinline__ const char* b_base(const Unit& u) const { return Bt + (size_t)u.pn * 256 * 2048; }
    __device__ __forceinline__ unsigned a_row(const Unit&, int) const { return 0u; }
    __device__ __forceinline__ bool is_hook(int) const { return false; }
    __device__ __forceinline__ void hook(Acc&, const Unit&, int, int, int, int, int) const {}
    __device__ __forceinline__ void epi(const Acc& acc, const Unit& u, int wr, int wc, int fr, int fq) const {
        EPI_ROWS(u);
        FOR_AI_M { const int row = row0 + ai * 128 + m * 16; const float rs = row_rstd(ss, row);
            f32x4 o[2];
#pragma unroll
            for (int n = 0; n < 2; ++n)
#pragma unroll
                for (int j = 0; j < 4; ++j) { const float a = acc[ai][0][m][n][j] * rs, b = acc[ai][1][m][n][j] * rs; o[n][j] = a * sigmoidf_(a) * b; }
            *(u32x4*)(U + (size_t)row * DFF + u.pn * 128 + cl) = pack8(o[0], o[1]); }
    }
};

struct MoeTiles {
    int tb[9];
    __device__ __forceinline__ void init(const unsigned* cnt  ) {
        int s = 0;
#pragma unroll
        for (int e = 0; e < 8; ++e) { tb[e] = s; s += ((int)cnt[64 * e] + 255) >> 8; }
        tb[8] = s;
    }
    __device__ __forceinline__ int expert(int rt) const { int e = 0;
#pragma unroll
        for (int k = 1; k < 8; ++k) e += (rt >= tb[k]) ? 1 : 0;
        return e; }
};

struct PolMoeUp : Order {
    static constexpr bool HOOK = false, GATHER = true;
    const char* A; const char* Bt; const int* list; const float* lr; bf16* U; MoeTiles mt;
    __device__ __forceinline__ int nt() const { return 16; }
    __device__ __forceinline__ int lda() const { return 2048; }
    __device__ __forceinline__ int ldb() const { return 2048; }
    __device__ __forceinline__ const char* a_base(const Unit&) const { return A; }
    __device__ __forceinline__ const char* b_base(const Unit& u) const { return Bt + (size_t)mt.expert(u.pm) * (2 * MFF) * 2048 + (size_t)u.pn * 256 * 2048; }
    __device__ __forceinline__ unsigned a_row(const Unit& u, int r) const { int tok = list[u.pm * 256 + r]; tok = tok < 0 ? 0 : tok; return (unsigned)tok * 2048u; }
    __device__ __forceinline__ bool is_hook(int) const { return false; }
    __device__ __forceinline__ void hook(Acc&, const Unit&, int, int, int, int, int) const {}
    __device__ __forceinline__ void epi(const Acc& acc, const Unit& u, int wr, int wc, int fr, int fq) const {
        EPI_ROWS(u);
        FOR_AI_M { const int row = row0 + ai * 128 + m * 16; const float rs = lr[row];
            f32x4 o[2];
#pragma unroll
            for (int n = 0; n < 2; ++n)
#pragma unroll
                for (int j = 0; j < 4; ++j) { const float a = acc[ai][0][m][n][j] * rs, b = acc[ai][1][m][n][j] * rs; o[n][j] = a * sigmoidf_(a) * b; }
            *(u32x4*)(U + (size_t)row * MFF + u.pn * 128 + cl) = pack8(o[0], o[1]); }
    }
};
struct PolMoeDown : Order {
    static constexpr bool HOOK = false, GATHER = false;
    const char* A; const char* Bt; const int* list; const float* lw; float* x; MoeTiles mt;
    __device__ __forceinline__ int nt() const { return MFF / 64; }
    __device__ __forceinline__ int lda() const { return MFF * 2; }
    __device__ __forceinline__ int ldb() const { return MFF * 2; }
    __device__ __forceinline__ const char* a_base(const Unit& u) const { return A + (size_t)u.pm * 256 * MFF * 2; }
    __device__ __forceinline__ const char* b_base(const Unit& u) const { return Bt + (size_t)mt.expert(u.pm) * D * MFF * 2 + (size_t)u.pn * 256 * MFF * 2; }
    __device__ __forceinline__ unsigned a_row(const Unit&, int) const { return 0u; }
    __device__ __forceinline__ bool is_hook(int) const { return false; }
    __device__ __forceinline__ void hook(Acc&, const Unit&, int, int, int, int, int) const {}
    __device__ __forceinline__ void epi(const Acc& acc, const Unit& u, int wr, int wc, int fr, int fq) const {
        EPI_ROWS(u);
        FOR_AI_M { const int row = row0 + ai * 128 + m * 16; const int tok = list[row]; const float w = lw[row];
            if (tok >= 0) { float* xp = x + (size_t)tok * D + u.pn * 256 + cl;
#pragma unroll
                for (int bj = 0; bj < 2; ++bj) { *(f32x4*)(xp + bj * 128) = *(const f32x4*)(xp + bj * 128) + acc[ai][bj][m][0] * w; *(f32x4*)(xp + bj * 128 + 4) = *(const f32x4*)(xp + bj * 128 + 4) + acc[ai][bj][m][1] * w; } } }
    }
};
}
struct Ctx {
    LAS unsigned char* lds; int tid, lane, wave, G, bid, gw, NGW;
};

__device__ __forceinline__ int zmap(int n) {
    const int pn = n >> 8, c = n & 255, bj = c >> 7, cc = c & 127;
    if (pn < 4) return OFF_A + (bj ? 512 : 0) + pn * 128 + cc;
    if (pn < 13) return OFF_Q + (pn - 4) * 256 + c;
    if (pn < 15) return OFF_CB + (pn - 13) * 256 + c;
    if (pn < 19) return (bj ? OFF_CH : OFF_CC) + (pn - 15) * 128 + cc;
    return OFF_G + (pn - 19) * 256 + c;
}
template <int MAP>
__device__ __forceinline__ void tr_matrix(const Ctx& F, const float* src, const float* src2, int K, int N, int ldsrc, bf16* dst, int lddst, int dstk0, const float* gain) {
    LAS float* scr = (LAS float*)(F.lds + F.wave * 16384);
    const int nblk = N / 32, nitems = (K / 64) * nblk, lane = F.lane;
    for (int it = F.gw; it < nitems; it += F.NGW) {
        const int kb = it / nblk, nb = it % nblk, k0 = 64 * kb, n0 = 32 * nb;
        const float* s = src; int sn0 = n0;
        if (MAP == 1) sn0 = zmap(n0);
        if (MAP == 2) { const int pn = n0 >> 8, c = n0 & 255; s = (c >> 7) ? src2 : src; sn0 = pn * 128 + (c & 127); }
#pragma unroll 8
        for (int i = 0; i < 32; ++i) { const int kk = 2 * i + (lane >> 5); float v = s[(size_t)(k0 + kk) * ldsrc + sn0 + (lane & 31)]; if (gain) v *= gain[k0 + kk]; scr[kk * 33 + (lane & 31)] = v; }
        LDS_WAIT(); asm volatile("" ::: "memory");
        const int c = lane & 7;
#pragma unroll
        for (int j = 0; j < 4; ++j) { const int n = (lane >> 3) + 8 * j; const LAS float* q = scr + (8 * c) * 33 + n;
            u32x4 o; o.x = pk2(q[0 * 33], q[1 * 33]); o.y = pk2(q[2 * 33], q[3 * 33]); o.z = pk2(q[4 * 33], q[5 * 33]); o.w = pk2(q[6 * 33], q[7 * 33]);
            *(u32x4*)(dst + (size_t)(n0 + n) * lddst + dstk0 + k0 + 8 * c) = o; }
        LDS_WAIT(); asm volatile("" ::: "memory");
    }
}
__device__ __forceinline__ void cv_rows(const Ctx& F, const float* src, bf16* dst, int R, const float* rowgain, float scale) {
    for (int r = F.gw; r < R; r += F.NGW) { const float g = rowgain[r] * scale; const f32x4* s = (const f32x4*)(src + (size_t)r * D) + F.lane; unsigned long long* o = (unsigned long long*)(dst + (size_t)r * D) + F.lane;
#pragma unroll
        for (int j = 0; j < 4; ++j) { const f32x4 v = s[64 * j] * g; o[64 * j] = (unsigned long long)pk2(v[0], v[1]) | ((unsigned long long)pk2(v[2], v[3]) << 32); } }
}
__device__ __forceinline__ void rows_raw_ss(const Ctx& F, const float* x, bf16* xb, float* ss) {
    for (int r = F.gw; r < M; r += F.NGW) { const f32x4* s = (const f32x4*)(x + (size_t)r * D) + F.lane; unsigned long long* o = (unsigned long long*)(xb + (size_t)r * D) + F.lane; float sq = 0.f;
#pragma unroll
        for (int j = 0; j < 4; ++j) { const f32x4 v = s[64 * j]; sq += (v[0] * v[0] + v[1] * v[1]) + (v[2] * v[2] + v[3] * v[3]); o[64 * j] = (unsigned long long)pk2(v[0], v[1]) | ((unsigned long long)pk2(v[2], v[3]) << 32); }
        sq = wave_sum(sq); if (F.lane < SSW) ss[(size_t)r * SSW + F.lane] = F.lane == 0 ? sq : 0.f; }
}
__device__ __forceinline__ void rows_rmsnorm_bf16(const Ctx& F, const float* x, const float* g, bf16* out, int R) {
    for (int r = F.gw; r < R; r += F.NGW) { const f32x4* s = (const f32x4*)(x + (size_t)r * D) + F.lane; const f32x4* gp = (const f32x4*)g + F.lane; unsigned long long* o = (unsigned long long*)(out + (size_t)r * D) + F.lane;
        f32x4 v[4]; float sq = 0.f;
#pragma unroll
        for (int j = 0; j < 4; ++j) { v[j] = s[64 * j]; sq += (v[j][0] * v[j][0] + v[j][1] * v[j][1]) + (v[j][2] * v[j][2] + v[j][3] * v[j][3]); }
        const float rs = __builtin_amdgcn_rsqf(wave_sum(sq) * (1.f / D) + EPS);
#pragma unroll
        for (int j = 0; j < 4; ++j) { const f32x4 w = v[j] * rs * gp[64 * j]; o[64 * j] = (unsigned long long)pk2(w[0], w[1]) | ((unsigned long long)pk2(w[2], w[3]) << 32); } }
}
__device__ __forceinline__ void rows_final_norm(const Ctx& F, float* x, const float* g) {
    for (int r = F.gw; r < M; r += F.NGW) { f32x4* s = (f32x4*)(x + (size_t)r * D) + F.lane; const f32x4* gp = (const f32x4*)g + F.lane;
        f32x4 v[4]; float sq = 0.f;
#pragma unroll
        for (int j = 0; j < 4; ++j) { v[j] = s[64 * j]; sq += (v[j][0] * v[j][0] + v[j][1] * v[j][1]) + (v[j][2] * v[j][2] + v[j][3] * v[j][3]); }
        const float rs = __builtin_amdgcn_rsqf(wave_sum(sq) * (1.f / D) + EPS);
#pragma unroll
        for (int j = 0; j < 4; ++j) s[64 * j] = v[j] * rs * gp[64 * j]; }
}

constexpr int DA_KP = 144, DA_VP = 528, DA_VOFF = 256 * DA_KP;
__device__ __forceinline__ void dil_attn_phase(const Ctx& F, bf16* QO, const bf16* Kg, const bf16* Vg, float* LSE) {
    const int tid = F.tid, w = F.wave, lane = F.lane, fr = lane & 15, fq = lane >> 4;
    LAS unsigned char* lds = F.lds;
    const float NINF = -__builtin_inff();
    for (int u = F.bid; u < NB * 3 * 4 * 128; u += F.G) {
        const int blk = u & 127, h = (u >> 7) & 3, g = (u >> 9) % 3, b = u / 1536;
        const int d = g == 0 ? 1 : (g == 1 ? 4 : 16), npr = 128 / d, r = blk / npr, n = blk % npr;
        const int col0 = g * 256 + h * 64;
        const size_t rb = (size_t)b * SEQ;
#pragma unroll
        for (int i = 0; i < 4; ++i) { const int c = tid + 512 * i, j = c >> 3, part = c & 7; const int lk = 128 * (n - 1) + j;
            u32x4 kv = (u32x4){0u, 0u, 0u, 0u}, vv = (u32x4){0u, 0u, 0u, 0u};
            if (lk >= 0) { const size_t off = (rb + (size_t)lk * d + r) * DW + col0 + part * 8; kv = *(const u32x4*)(Kg + off); vv = *(const u32x4*)(Vg + off); }
            *(LAS u32x4*)(lds + j * DA_KP + part * 16) = kv;
            LAS bf16* vt = (LAS bf16*)(lds + DA_VOFF) + j;
#pragma unroll
            for (int e = 0; e < 4; ++e) { const unsigned x = vv[e]; vt[(part * 8 + 2 * e) * (DA_VP / 2)] = (bf16)(x & 0xffffu); vt[(part * 8 + 2 * e + 1) * (DA_VP / 2)] = (bf16)(x >> 16); } }
        const int qi = 16 * w + fr; const size_t rowq = rb + (size_t)(128 * n + qi) * d + r;
        bf16x8 qf[2];
#pragma unroll
        for (int ks = 0; ks < 2; ++ks) qf[ks] = *(const bf16x8*)(QO + rowq * DW + col0 + 32 * ks + 8 * fq);
        __syncthreads();
        f32x4 s[10];
#pragma unroll
        for (int kb = 0; kb < 10; ++kb) { const int kbc = (w + kb) < 15 ? (w + kb) : 15; s[kb] = (f32x4){0.f, 0.f, 0.f, 0.f};
#pragma unroll
            for (int ks = 0; ks < 2; ++ks) { const bf16x8 a = *(const LAS bf16x8*)(lds + (16 * kbc + fr) * DA_KP + (32 * ks + 8 * fq) * 2); s[kb] = __builtin_amdgcn_mfma_f32_16x16x32_bf16(a, qf[ks], s[kb], 0, 0, 0); } }
        float mx = NINF;
#pragma unroll
        for (int kb = 0; kb < 10; ++kb)
#pragma unroll
            for (int i = 0; i < 4; ++i) { const int j = 16 * (w + kb) + 4 * fq + i, dist = 128 + qi - j; const bool ok = dist >= 0 && dist <= 128 && (n > 0 || j >= 128); s[kb][i] = ok ? s[kb][i] : NINF; mx = fmaxf(mx, s[kb][i]); }
        mx = fmaxf(mx, __shfl_xor(mx, 16)); mx = fmaxf(mx, __shfl_xor(mx, 32));
        float sm = 0.f;
#pragma unroll
        for (int kb = 0; kb < 10; ++kb)
#pragma unroll
            for (int i = 0; i < 4; ++i) { s[kb][i] = fexp2(s[kb][i] - mx); sm += s[kb][i]; }
        sm += __shfl_xor(sm, 16); sm += __shfl_xor(sm, 32);
        f32x4 o[4];
#pragma unroll
        for (int eb = 0; eb < 4; ++eb) o[eb] = (f32x4){0.f, 0.f, 0.f, 0.f};
#pragma unroll
        for (int c = 0; c < 5; ++c) { const int ka = (w + 2 * c) < 15 ? (w + 2 * c) : 15, kb2 = (w + 2 * c + 1) < 15 ? (w + 2 * c + 1) : 15;
            const u32x4 pw = pack8(s[2 * c], s[2 * c + 1]); const bf16x8 pb = __builtin_bit_cast(bf16x8, pw);
#pragma unroll
            for (int eb = 0; eb < 4; ++eb) { const LAS unsigned char* vr = lds + DA_VOFF + (16 * eb + fr) * DA_VP;
                const u32x2 va = *(const LAS u32x2*)(vr + (16 * ka + 4 * fq) * 2), vb = *(const LAS u32x2*)(vr + (16 * kb2 + 4 * fq) * 2);
                const u32x4 vw = (u32x4){va.x, va.y, vb.x, vb.y};
                o[eb] = __builtin_amdgcn_mfma_f32_16x16x32_bf16(__builtin_bit_cast(bf16x8, vw), pb, o[eb], 0, 0, 0); } }
        const float inv = 1.f / sm;
#pragma unroll
        for (int eb = 0; eb < 4; ++eb) { u32x2 ow; ow.x = cvt_pk_bf16(o[eb][0] * inv, o[eb][1] * inv); ow.y = cvt_pk_bf16(o[eb][2] * inv, o[eb][3] * inv);
            *(u32x2*)(QO + rowq * DW + col0 + 16 * eb + 4 * fq) = ow; }
        if (fq == 0) LSE[rowq * 12 + g * 4 + h] = mx + __builtin_amdgcn_logf(sm);
        __syncthreads();
    }
}

constexpr int TH_XB = 0, TH_WOFF = 98304;
__device__ __forceinline__ void thin_phase(const Ctx& F, const bf16* AG, const bf16* GB, const bf16* CP, const bf16* OG, const float* LSE,
                                           const float* acw, const float* acb, const float* lng, const float* lnb, const float* ccw, bf16* ACT) {
    const int tid = F.tid, w = F.wave, lane = F.lane;
    LAS unsigned char* lds = F.lds;
    for (int i = tid; i < CAK * CA; i += NTHR) ((LAS bf16*)(lds + TH_WOFF))[i] = (bf16)f2bf(acw[i]);
    f32x4 cb[2], lg[2], lb[2];
#pragma unroll
    for (int q = 0; q < 2; ++q) { cb[q] = *(const f32x4*)(acb + 8 * lane + 4 * q); lg[q] = *(const f32x4*)(lng + 8 * lane + 4 * q); lb[q] = *(const f32x4*)(lnb + 8 * lane + 4 * q); }
    for (int s = F.bid; s < M / 64; s += F.G) {
        const int b = s / (SEQ / 64), t0 = (s % (SEQ / 64)) * 64; const size_t rb = (size_t)b * SEQ;
        for (int c = tid; c < 94 * 64; c += NTHR) { const int rr = c >> 6, part = c & 63, tt = t0 - 30 + rr;
            u32x4 v = (u32x4){0u, 0u, 0u, 0u}; if (tt >= 0) v = *(const u32x4*)(AG + (rb + tt) * CA + part * 8);
            *(LAS u32x4*)(lds + TH_XB + rr * 1024 + part * 16) = v; }
        __syncthreads();
        {
            f32x4 acc[8][2];
#pragma unroll
            for (int j = 0; j < 8; ++j) { acc[j][0] = cb[0]; acc[j][1] = cb[1]; }
            for (int k = 0; k < CAK; ++k) { const u32x4 ww = *(const LAS u32x4*)(lds + TH_WOFF + k * 1024 + lane * 16); f32x4 w0, w1; unpack8(ww, w0, w1);
#pragma unroll
                for (int j = 0; j < 8; ++j) { const u32x4 xv = *(const LAS u32x4*)(lds + TH_XB + (8 * w + j + k) * 1024 + lane * 16); f32x4 x0, x1; unpack8(xv, x0, x1); acc[j][0] += w0 * x0; acc[j][1] += w1 * x1; } }
#pragma unroll
            for (int j = 0; j < 8; ++j) { const f32x4 a0 = acc[j][0], a1 = acc[j][1];
                const float mean = wave_sum((a0[0] + a0[1]) + (a0[2] + a0[3]) + (a1[0] + a1[1]) + (a1[2] + a1[3])) * (1.f / CA);
                const f32x4 d0 = a0 - mean, d1 = a1 - mean;
                const float var = wave_sum((d0[0] * d0[0] + d0[1] * d0[1]) + (d0[2] * d0[2] + d0[3] * d0[3]) + (d1[0] * d1[0] + d1[1] * d1[1]) + (d1[2] * d1[2] + d1[3] * d1[3])) * (1.f / CA);
                const float rs = __builtin_amdgcn_rsqf(var + EPS);
                f32x4 y0 = d0 * rs * lg[0] + lb[0], y1 = d1 * rs * lg[1] + lb[1];
#pragma unroll
                for (int q = 0; q < 4; ++q) { y0[q] *= sigmoidf_(y0[q]); y1[q] *= sigmoidf_(y1[q]); }
                *(u32x4*)(ACT + (rb + t0 + 8 * w + j) * KCAT + 8 * lane) = pack8(y0, y1); }
        }
#pragma unroll 2
        for (int i = 0; i < 8; ++i) { const int idx = tid + NTHR * i, tok = idx >> 6, part = idx & 63, t = t0 + tok; const size_t row = rb + t;
            const u32x4 gbw = *(const u32x4*)(GB + row * CS + part * 8), c0w = *(const u32x4*)(CP + row * CS + part * 8);
            u32x4 c1w = (u32x4){0u, 0u, 0u, 0u}, c2w = (u32x4){0u, 0u, 0u, 0u};
            if (t >= 1) c1w = *(const u32x4*)(CP + (row - 1) * CS + part * 8);
            if (t >= 2) c2w = *(const u32x4*)(CP + (row - 2) * CS + part * 8);
            f32x4 g0, g1, p0, p1, q0, q1, r0, r1; unpack8(gbw, g0, g1); unpack8(c0w, p0, p1); unpack8(c1w, q0, q1); unpack8(c2w, r0, r1);
            const f32x4 wa0 = *(const f32x4*)(ccw + part * 8), wa1 = *(const f32x4*)(ccw + part * 8 + 4), wb0 = *(const f32x4*)(ccw + CS + part * 8), wb1 = *(const f32x4*)(ccw + CS + part * 8 + 4),
                        wc0 = *(const f32x4*)(ccw + 2 * CS + part * 8), wc1 = *(const f32x4*)(ccw + 2 * CS + part * 8 + 4);
            const f32x4 y0 = g0 * (wc0 * p0 + wb0 * q0 + wa0 * r0), y1 = g1 * (wc1 * p1 + wb1 * q1 + wa1 * r1);
            *(u32x4*)(ACT + row * KCAT + 768 + part * 8) = pack8(y0, y1); }
#pragma unroll 2
        for (int i = 0; i < 4; ++i) { const int idx = tid + NTHR * i, tok = idx >> 5, h = (idx >> 3) & 3, part = idx & 7; const size_t row = rb + t0 + tok;
            const float l0 = LSE[row * 12 + h], l1 = LSE[row * 12 + 4 + h], l2 = LSE[row * 12 + 8 + h]; const float mx = fmaxf(l0, fmaxf(l1, l2));
            float w0 = fexp2(l0 - mx), w1 = fexp2(l1 - mx), w2 = fexp2(l2 - mx); const float inv = 1.f / (w0 + w1 + w2); w0 *= inv; w1 *= inv; w2 *= inv;
            const bf16* op = OG + row * DW + h * 64 + part * 8;
            f32x4 a0, a1, b0, b1, c0, c1; unpack8(*(const u32x4*)op, a0, a1); unpack8(*(const u32x4*)(op + 256), b0, b1); unpack8(*(const u32x4*)(op + 512), c0, c1);
            *(u32x4*)(ACT + row * KCAT + 512 + h * 64 + part * 8) = pack8(a0 * w0 + b0 * w1 + c0 * w2, a1 * w0 + b1 * w1 + c1 * w2); }
        __syncthreads();
    }
}

__device__ __forceinline__ void router_phase(const Ctx& F, const float* x, const float* g, const float* wr, unsigned char* rt, gu32* cnt) {
    const int tid = F.tid, w = F.wave, lane = F.lane;
    LAS int* hist = (LAS int*)F.lds;
    int* RE = (int*)(rt + RT_E); float* RW = (float*)(rt + RT_W); float* RS = (float*)(rt + RT_RS); int* POS = (int*)(rt + RT_POS); int* BB = (int*)(rt + RT_BB);
    f32x4 wreg[4][8];
#pragma unroll
    for (int jj = 0; jj < 4; ++jj) { const int k0 = 4 * lane + 256 * jj; const f32x4 gv = *(const f32x4*)(g + k0);
#pragma unroll
        for (int e = 0; e < 8; ++e) wreg[jj][e] = (f32x4){wr[(k0 + 0) * NE + e] * gv[0], wr[(k0 + 1) * NE + e] * gv[1], wr[(k0 + 2) * NE + e] * gv[2], wr[(k0 + 3) * NE + e] * gv[3]}; }
    for (int vb = F.bid; vb < 256; vb += F.G) {
        if (tid < 16) hist[tid] = 0;
        __syncthreads();
        for (int j = 0; j < 16; ++j) { const int tok = vb * 128 + 16 * w + j; const f32x4* xr = (const f32x4*)(x + (size_t)tok * D) + lane;
            float sq = 0.f, lg[8];
#pragma unroll
            for (int e = 0; e < 8; ++e) lg[e] = 0.f;
#pragma unroll
            for (int jj = 0; jj < 4; ++jj) { const f32x4 v = xr[64 * jj]; sq += (v[0] * v[0] + v[1] * v[1]) + (v[2] * v[2] + v[3] * v[3]);
#pragma unroll
                for (int e = 0; e < 8; ++e) lg[e] += (v[0] * wreg[jj][e][0] + v[1] * wreg[jj][e][1]) + (v[2] * wreg[jj][e][2] + v[3] * wreg[jj][e][3]); }
            sq = wave_sum(sq); const float rs = __builtin_amdgcn_rsqf(sq * (1.f / D) + EPS);
#pragma unroll
            for (int e = 0; e < 8; ++e) lg[e] = wave_sum(lg[e]) * rs;
            int e1 = 0; float v1 = lg[0];
#pragma unroll
            for (int e = 1; e < 8; ++e) if (lg[e] > v1) { v1 = lg[e]; e1 = e; }
            int e2 = -1; float v2 = -3.0e38f;
#pragma unroll
            for (int e = 0; e < 8; ++e) if (e != e1 && lg[e] > v2) { v2 = lg[e]; e2 = e; }
            const float w1 = 1.f / (1.f + __expf(v2 - v1)), w2 = 1.f - w1;
            if (lane == 0) { const int r1 = atomicAdd((int*)(hist + e1), 1), r2 = atomicAdd((int*)(hist + 8 + e2), 1);
                RE[tok] = e1 | (e2 << 8); RW[2 * tok] = w1; RW[2 * tok + 1] = w2; RS[tok] = rs; POS[2 * tok] = r1; POS[2 * tok + 1] = r2; } }
        __syncthreads();
        if (tid < 16) { const int c = hist[tid]; int base = 0; if (c > 0) base = (int)__hip_atomic_fetch_add(cnt + 64 * tid, (unsigned)c, RLX_AGENT); BB[vb * 16 + tid] = base; }
        __syncthreads();
    }
}
__device__ __forceinline__ int tbsel(const pol::MoeTiles& mt, int e) { int t = 0;
#pragma unroll
    for (int k = 0; k < 8; ++k) t = (k == e) ? mt.tb[k] : t;
    return t; }
__device__ __forceinline__ void lists_phase(const Ctx& F, unsigned char* rt, const unsigned* cnt) {
    const int* RE = (const int*)(rt + RT_E); const float* RW = (const float*)(rt + RT_W); const float* RS = (const float*)(rt + RT_RS); const int* POS = (const int*)(rt + RT_POS); const int* BB = (const int*)(rt + RT_BB);
    int* LIST = (int*)(rt + RT_LIST); float* LW = (float*)(rt + RT_LW); float* LR = (float*)(rt + RT_LR);
    pol::MoeTiles mt0, mt1; mt0.init(cnt); mt1.init(cnt + 64 * 8);
    const int gt = F.bid * NTHR + F.tid, NT = F.G * NTHR;
    for (int tok = gt; tok < M; tok += NT) { const int ee = RE[tok], vb = tok >> 7; const float rs = RS[tok];
#pragma unroll
        for (int p = 0; p < 2; ++p) { const int e = (ee >> (8 * p)) & 255; const int tb = p ? tbsel(mt1, e) : tbsel(mt0, e);
            const int slot = 256 * tb + BB[vb * 16 + p * 8 + e] + POS[2 * tok + p];
            LIST[p * MOE_ROWS + slot] = tok; LW[p * MOE_ROWS + slot] = RW[2 * tok + p]; LR[p * MOE_ROWS + slot] = rs; } }
    for (int idx = gt; idx < 2 * 8 * 256; idx += NT) { const int p = idx >> 11, e = (idx >> 8) & 7, i = idx & 255; const int c = (int)cnt[64 * (p * 8 + e)], rem = c & 255;
        if (rem != 0 && i >= rem) { const int tb = p ? tbsel(mt1, e) : tbsel(mt0, e); const int slot = 256 * (tb + (c >> 8)) + i;
            LIST[p * MOE_ROWS + slot] = -1; LW[p * MOE_ROWS + slot] = 0.f; LR[p * MOE_ROWS + slot] = 0.f; } }
}
constexpr int RING_BYTES = 131072, XCH_OFF = RING_BYTES, MISC_OFF = XCH_OFF + 16384, LDS_BYTES = MISC_OFF + 256;
constexpr int NPH = 26;
struct Args { const float* in[29]; float* out; unsigned char* ws; int ph_lo, ph_hi; };

__global__ void __launch_bounds__(NTHR, 2) mk_fwd(Args args) {
    extern __shared__ __attribute__((aligned(16))) unsigned char lds_raw[];
    Ctx F0; F0.lds = (LAS unsigned char*)lds_raw; F0.tid = threadIdx.x; F0.lane = F0.tid & 63; F0.wave = __builtin_amdgcn_readfirstlane(F0.tid >> 6);
    F0.G = gridDim.x; F0.bid = blockIdx.x; F0.gw = F0.bid * NWAVES + F0.wave; F0.NGW = F0.G * NWAVES;
    const Ctx& F = F0;
    volatile LAS unsigned* MISC = (volatile LAS unsigned*)(F.lds + MISC_OFF);
    if (F.tid < 64) MISC[F.tid] = 0u;
    __syncthreads();
    const int lo = args.ph_lo, hi = args.ph_hi;
    XcdBarrier bar; bar.bar = (unsigned*)(args.ws + WS_CTL) + CW_BAR; bar.x = 0; bar.st = MISC + 8;
    if (hi - lo > 1) bar = xcd_barrier_post((unsigned*)(args.ws + WS_CTL) + CW_BAR, MISC + 8);
    typedef const __attribute__((address_space(4))) Args* KArgs;
#define PHASE_ARGS Ctx F = F0; asm volatile("" : "+v"(F.tid), "+v"(F.lane)); KArgs ka = (KArgs)__builtin_amdgcn_kernarg_segment_ptr(); asm volatile("" : "+s"(ka)); unsigned char* ws = ka->ws; unsigned char* R1 = ws + WS_R1; (void)R1;
#define INP(k) (ka->in[k])
#ifndef MK_MASK
#define MK_MASK 0xFFFFFFFFu
#endif
#define EN(s) (((MK_MASK) >> (s)) & 1u)
#define IN(k) (lo <= (k) && (k) < hi)
#define SEAM(k) do { if (IN(k) && IN((k) + 1)) { XcdBarrier b2_ = bar; asm volatile("" : "+s"(b2_.bar), "+s"(b2_.x)); xcd_barrier(b2_); } } while (0)
    LAS unsigned char* ring = F0.lds;
#define SSP ((float*)(ws + WS_SS))
#define XBP ((bf16*)(ws + WS_XB))
#define OUTP (ka->out)

    if (EN(0) && IN(0)) { PHASE_ARGS
        for (int l = 0; l < 2; ++l) {
            unsigned char* wl = ws + WS_W + (size_t)l * W_LAYER;
            tr_matrix<1>(F, INP(3) + (size_t)l * D * NIN, nullptr, D, NIN, NIN, (bf16*)(wl + W_WIN), D, 0, INP(2) + l * D);
            tr_matrix<0>(F, INP(9) + (size_t)l * CA * D, nullptr, CA, D, D, (bf16*)(wl + W_WCAT), KCAT, 0, nullptr);
            tr_matrix<0>(F, INP(10) + (size_t)l * DO * D, nullptr, DO, D, D, (bf16*)(wl + W_WCAT), KCAT, 512, nullptr);
            tr_matrix<0>(F, INP(12) + (size_t)l * CS * D, nullptr, CS, D, D, (bf16*)(wl + W_WCAT), KCAT, 768, nullptr);
            tr_matrix<0>(F, INP(13) + (size_t)l * D * D, nullptr, D, D, D, (bf16*)(wl + W_WO), D, 0, nullptr);
            bf16* wkv = (bf16*)(R1 + R_WKV) + (size_t)l * 2048 * D;
            tr_matrix<0>(F, INP(17) + (size_t)l * D * D, nullptr, D, D, D, wkv, D, 0, nullptr);
            tr_matrix<0>(F, INP(18) + (size_t)l * D * D, nullptr, D, D, D, wkv + (size_t)D * D, D, 0, nullptr);
            tr_matrix<0>(F, INP(19) + (size_t)l * D * D, nullptr, D, D, D, (bf16*)(R1 + R_WOT) + (size_t)l * D * D, D, 0, nullptr);
            cv_rows(F, INP(16) + (size_t)l * D * D, (bf16*)(R1 + R_WQ) + (size_t)l * D * D, D, INP(14) + l * D, CX);
            rows_rmsnorm_bf16(F, INP(1), INP(15) + l * D, (bf16*)(R1 + R_MN) + (size_t)l * 512 * D, NB * MEM);
            float* bz = (float*)(ws + WS_BZ) + l * NIN; const float* bi = INP(4) + l * NIN;
            for (int n = F.bid * NTHR + F.tid; n < NIN; n += F.G * NTHR) bz[n] = bi[zmap(n)];
        }
        tr_matrix<2>(F, INP(21), INP(22), D, 2 * DFF, DFF, (bf16*)(ws + WS_WFF + WFF_W13), D, 0, INP(20));
        tr_matrix<0>(F, INP(23), nullptr, DFF, D, D, (bf16*)(ws + WS_WFF + WFF_W2), DFF, 0, nullptr);
        rows_raw_ss(F, INP(0), XBP, SSP);
    }
    SEAM(0);
    if (EN(1) && IN(1)) { PHASE_ARGS
        pol::PolPlain p; p.init(4, 8, F.G, F.bid);
        p.A = (const char*)(R1 + R_MN); p.Bt = (const char*)(R1 + R_WKV); p.C = (char*)(R1 + R_KM); p.lda_ = 2048; p.ldb_ = 2048; p.ldc_ = 4096; p.nt_ = 16;
        p.mper = 2; p.n0 = 1; p.n1 = 1; p.a0 = p.a1 = 0; p.a2 = (size_t)512 * 2048; p.b0 = p.b1 = 0; p.b2 = (size_t)2048 * 2048; p.c0 = p.c1 = 0; p.c2 = (size_t)512 * 4096;
        pg8::gemm_phase<pol::PolPlain, true>(ring, p);
    }
    SEAM(1);
    if (IN(2)) { PHASE_ARGS
        if (EN(2)) {   pol::PolPlain p; p.init(16, 4, F.G, F.bid);
            p.A = (const char*)(R1 + R_KM); p.Bt = (const char*)(R1 + R_WQ); p.C = (char*)(ws + WS_WQK); p.lda_ = 4096; p.ldb_ = 2048; p.ldc_ = 2048; p.nt_ = 4;
            p.mper = 1; p.n0 = 4; p.n1 = 2; p.a0 = 512; p.a1 = (size_t)256 * 4096; p.a2 = (size_t)512 * 4096; p.b0 = 512; p.b1 = 0; p.b2 = (size_t)D * 2048;
            p.c0 = (size_t)256 * 2048; p.c1 = (size_t)D * 2048; p.c2 = (size_t)2 * D * 2048;
            pg8::gemm_phase<pol::PolPlain, true>(ring, p); }
        if (EN(3)) {   pol::PolPlain p; p.init(64, 1, F.G, (F.bid + F.G / 2) % F.G);
            p.A = (const char*)(R1 + R_WOT); p.Bt = (const char*)(R1 + R_KM) + 2048; p.C = (char*)(ws + WS_WVO); p.lda_ = 2048; p.ldb_ = 4096; p.ldc_ = 2048; p.nt_ = 4;
            p.mper = 4; p.n0 = 4; p.n1 = 2; p.a0 = 512; p.a1 = 0; p.a2 = (size_t)D * 2048; p.b0 = 512; p.b1 = (size_t)256 * 4096; p.b2 = (size_t)512 * 4096;
            p.c0 = 512; p.c1 = (size_t)D * 2048; p.c2 = (size_t)2 * D * 2048;
            pg8::gemm_phase<pol::PolPlain, true>(ring, p); }
    }
    SEAM(2);

    for (int l = 0; l < 2; ++l) {
        const int pb = l == 0 ? 3 : 12;
#define WL (ws + WS_W + (size_t)l * W_LAYER)
#define AGP ((bf16*)(R1 + R_AG))
#define GBP ((bf16*)(R1 + R_GB))
#define CPP ((bf16*)(R1 + R_CP))
#define QP ((bf16*)(R1 + R_Q))
#define KP ((bf16*)(R1 + R_K))
#define VP ((bf16*)(R1 + R_V))
#define GTP ((bf16*)(R1 + R_G))
#define ACTP ((bf16*)(R1 + R_ACT))
#define MRGP ((bf16*)(R1 + R_MRG))
#define PBP ((bf16*)(R1 + R_P))
#define LSEP ((float*)(ws + WS_LSE))
#define SSA (SSP + (size_t)(3 * l) * M * SSW)
        if (EN(4) && IN(pb + 0)) { PHASE_ARGS
            pol::PolZ p; p.init(M / 256, NIN / 256, F.G, F.bid);
            p.A = (const char*)XBP; p.Bt = (const char*)(WL + W_WIN); p.ss = SSA; p.bz = (const float*)(ws + WS_BZ) + l * NIN;
            p.R1 = R1;
            pg8::gemm_phase<pol::PolZ, true>(ring, p);
        }
        SEAM(pb + 0);
        if (EN(5) && IN(pb + 1)) { PHASE_ARGS dil_attn_phase(F, QP, KP, VP, LSEP); }
        SEAM(pb + 1);
        if (EN(6) && IN(pb + 2)) { PHASE_ARGS thin_phase(F, AGP, GBP, CPP, QP, LSEP, INP(5) + l * CAK * CA, INP(6) + l * CA, INP(7) + l * CA, INP(8) + l * CA, INP(11) + l * 3 * CS, ACTP); }
        SEAM(pb + 2);
        if (EN(7) && IN(pb + 3)) { PHASE_ARGS
            pol::PolMerge p; p.init(M / 256, 4, F.G, F.bid);
            p.A = (const char*)ACTP; p.Bt = (const char*)(WL + W_WCAT); p.Gt = GTP; p.MRG = MRGP;
            pg8::gemm_phase<pol::PolMerge, true>(ring, p);
        }
        SEAM(pb + 3);
        if (EN(8) && IN(pb + 4)) { PHASE_ARGS
            if (l == 1) {
                for (int e = 0; e < NE; ++e) {
                    tr_matrix<2>(F, INP(25) + (size_t)e * D * MFF, INP(26) + (size_t)e * D * MFF, D, 2 * MFF, MFF, (bf16*)(R1 + R_MW13) + (size_t)e * 2 * MFF * D, D, 0, INP(20) + D);
                    tr_matrix<0>(F, INP(27) + (size_t)e * MFF * D, nullptr, MFF, D, D, (bf16*)(R1 + R_MW2) + (size_t)e * D * MFF, MFF, 0, nullptr);
                }
                __syncthreads();
            }
            pol::PolRes p; p.init(M / 256, 4, F.G, F.bid);
            p.A = (const char*)MRGP; p.Bt = (const char*)(WL + W_WO); p.b_batch = 0; p.K = D; p.xin = l == 0 ? INP(0) : OUTP; p.xout = OUTP; p.XB = XBP; p.ssn = SSA + (size_t)M * SSW;
            pg8::gemm_phase<pol::PolRes, true>(ring, p);
        }
        SEAM(pb + 4);
        if (EN(9) && IN(pb + 5)) { PHASE_ARGS
            pol::PolXS p; p.init(M / 256, 4, F.G, F.bid);
            p.A = (const char*)XBP; p.Bt = (const char*)(ws + WS_WQK) + (size_t)l * 2 * D * 2048; p.b_batch = (size_t)D * 2048; p.ss = SSA + (size_t)M * SSW; p.P = PBP; p.xch = (LAS float*)(F.lds + XCH_OFF); p.parity = 0;
            pg8::gemm_phase<pol::PolXS, true>(ring, p);
        }
        SEAM(pb + 5);
        if (EN(10) && IN(pb + 6)) { PHASE_ARGS
            pol::PolRes p; p.init(M / 256, 4, F.G, F.bid);
            p.A = (const char*)PBP; p.Bt = (const char*)(ws + WS_WVO) + (size_t)l * 2 * D * 2048; p.b_batch = (size_t)D * 2048; p.K = D; p.xin = OUTP; p.xout = OUTP; p.XB = XBP; p.ssn = SSA + (size_t)2 * M * SSW;
            pg8::gemm_phase<pol::PolRes, true>(ring, p);
        }
        SEAM(pb + 6);
        if (l == 0) {
            if (EN(11) && IN(pb + 7)) { PHASE_ARGS
                pol::PolUp p; p.init(M / 256, 2 * DFF / 256, F.G, F.bid);
                p.A = (const char*)XBP; p.Bt = (const char*)(ws + WS_WFF + WFF_W13); p.ss = SSA + (size_t)2 * M * SSW; p.U = (bf16*)(R1 + R_U);
                pg8::gemm_phase<pol::PolUp, true>(ring, p);
            }
            SEAM(pb + 7);
            if (EN(12) && IN(pb + 8)) { PHASE_ARGS
                pol::PolRes p; p.init(M / 256, 4, F.G, F.bid);
                p.A = (const char*)(R1 + R_U); p.Bt = (const char*)(ws + WS_WFF + WFF_W2); p.b_batch = 0; p.K = DFF; p.xin = OUTP; p.xout = OUTP; p.XB = XBP; p.ssn = SSP + (size_t)3 * M * SSW;
                pg8::gemm_phase<pol::PolRes, true>(ring, p);
            }
            SEAM(pb + 8);
        } else {
#define RTP (ws + WS_RT)
#define CNTP ((gu32*)(ws + WS_CTL) + CW_CNT)
            if (EN(13) && IN(pb + 7)) { PHASE_ARGS router_phase(F, OUTP, INP(20) + D, INP(24), RTP, CNTP); }
            SEAM(pb + 7);
            if (EN(14) && IN(pb + 8)) { PHASE_ARGS lists_phase(F, RTP, (const unsigned*)CNTP); }
            SEAM(pb + 8);
            for (int ps = 0; ps < 2; ++ps) {
                if (EN(15) && IN(pb + 9 + 2 * ps)) { PHASE_ARGS
                    unsigned char* rt = RTP; const unsigned* cnt = (const unsigned*)CNTP + 64 * 8 * ps; const int* list = (const int*)(rt + RT_LIST) + ps * MOE_ROWS;
                    pol::PolMoeUp p; p.mt.init(cnt); p.init(p.mt.tb[8], 2 * MFF / 256, F.G, F.bid);
                    p.A = (const char*)XBP; p.Bt = (const char*)(R1 + R_MW13); p.list = list; p.lr = (const float*)(rt + RT_LR) + ps * MOE_ROWS; p.U = (bf16*)(R1 + R_U);
                    pg8::gemm_phase<pol::PolMoeUp, true>(ring, p);
                }
                SEAM(pb + 9 + 2 * ps);
                if (EN(16) && IN(pb + 10 + 2 * ps)) { PHASE_ARGS
                    unsigned char* rt = RTP; const unsigned* cnt = (const unsigned*)CNTP + 64 * 8 * ps; const int* list = (const int*)(rt + RT_LIST) + ps * MOE_ROWS;
                    pol::PolMoeDown p; p.mt.init(cnt); p.init(p.mt.tb[8], 4, F.G, F.bid);
                    p.A = (const char*)(R1 + R_U); p.Bt = (const char*)(R1 + R_MW2); p.list = list; p.lw = (const float*)(rt + RT_LW) + ps * MOE_ROWS; p.x = OUTP;
                    pg8::gemm_phase<pol::PolMoeDown, true>(ring, p);
                }
                SEAM(pb + 10 + 2 * ps);
            }
        }
    }
    if (EN(17) && IN(25)) { PHASE_ARGS rows_final_norm(F, OUTP, INP(28)); }
#undef IN
#undef SEAM
}
#if MK_DEBUG
namespace dbg {
constexpr int TN = 2304, NS = 32, NCK = 33;
__device__ const int SAMP[NS] = {0, 1, 2, 3, 29, 30, 31, 32, 63, 64, 127, 128, 129, 255, 256, 511, 512, 640, 1023, 1024, 1500, 2047, 2048, 2049, 2050, 2079, 2080, 2175, 2176, 2177, 2200, 2303};
__host__ __device__ constexpr int ck_w(int ck) { const int k = ck % 16; return ck == 32 ? 1024 : (k == 0 ? 512 : k <= 3 ? 768 : k <= 5 ? 512 : k == 6 ? 3072 : k == 7 ? 512 : k <= 12 ? 1024 : k == 13 ? 256 : k == 14 ? 512 : 0); }
__host__ __device__ inline size_t ck_off(int ck) { size_t o = 0; for (int i = 0; i < ck; ++i) o += (size_t)NS * ck_w(i); return o; }
constexpr size_t O_X = 0, O_HN = O_X + (size_t)TN * 1024, O_Z = O_HN + (size_t)TN * 1024, O_A0 = O_Z + (size_t)TN * NIN, O_A1 = O_A0 + (size_t)TN * 512, O_A2 = O_A1 + (size_t)TN * 512,
    O_SC = O_A2 + (size_t)TN * 512, O_ST = O_SC + (size_t)TN * 12 * 129, O_OG = O_ST + (size_t)TN * 12 * 2, O_O = O_OG + (size_t)TN * 768, O_C2 = O_O + (size_t)TN * 256,
    O_YA = O_C2 + (size_t)TN * 512, O_YB = O_YA + (size_t)TN * 1024, O_YC = O_YB + (size_t)TN * 1024, O_MRG = O_YC + (size_t)TN * 1024, O_T = O_MRG + (size_t)TN * 1024,
    O_MEMN = O_T + (size_t)TN * 1024, O_KM = O_MEMN + 256 * 1024, O_VM = O_KM + 256 * 1024, O_XS = O_VM + 256 * 1024, O_XO = O_XS + (size_t)TN * 1024,
    O_FA = O_XO + (size_t)TN * 1024, O_FB = O_FA + (size_t)TN * 3584 * 2, O_LG = O_FB + (size_t)TN * 3584 * 2, O_RT = O_LG + (size_t)TN * 8, O_END = O_RT + (size_t)TN * 4;
static_assert(O_END * 4 <= 432 * MiB, "oracle buffers fit R1");

__global__ void k_copy(const float* s, float* d, size_t n) { for (size_t i = blockIdx.x * (size_t)blockDim.x + threadIdx.x; i < n; i += (size_t)gridDim.x * blockDim.x) d[i] = s[i]; }
__global__ void k_rms(const float* x, const float* g, float* o, int rows) {
    __shared__ float red[256];
    for (int r = blockIdx.x; r < rows; r += gridDim.x) { float s = 0.f; for (int c = threadIdx.x; c < 1024; c += 256) { const float v = x[(size_t)r * 1024 + c]; s += v * v; }
        red[threadIdx.x] = s; __syncthreads(); for (int o2 = 128; o2 > 0; o2 >>= 1) { if ((int)threadIdx.x < o2) red[threadIdx.x] += red[threadIdx.x + o2]; __syncthreads(); }
        const float rs = 1.f / sqrtf(red[0] / 1024.f + EPS); __syncthreads();
        for (int c = threadIdx.x; c < 1024; c += 256) o[(size_t)r * 1024 + c] = x[(size_t)r * 1024 + c] * rs * g[c]; }
}
__global__ void k_gemm(const float* A, int lda, const float* W, int ldw, const float* bias, float* C, int ldc, int rows, int N, int K) {
    const size_t tot = (size_t)rows * N;
    for (size_t i = blockIdx.x * (size_t)blockDim.x + threadIdx.x; i < tot; i += (size_t)gridDim.x * blockDim.x) { const int r = (int)(i / N), n = (int)(i % N); float acc = 0.f;
        for (int k = 0; k < K; ++k) acc += A[(size_t)r * lda + k] * W[(size_t)k * ldw + n];
        C[(size_t)r * ldc + n] = acc + (bias ? bias[n] : 0.f); }
}
__device__ inline float sigm(float x) { return 1.f / (1.f + expf(-x)); }
__global__ void k_glu(const float* z, float* a0) { for (int i = blockIdx.x * blockDim.x + threadIdx.x; i < TN * 512; i += gridDim.x * blockDim.x) { const int t = i / 512, c = i % 512; a0[i] = z[(size_t)t * NIN + c] * sigm(z[(size_t)t * NIN + 512 + c]); } }
__global__ void k_conv31(const float* a0, const float* w, const float* b, float* a1) { for (int i = blockIdx.x * blockDim.x + threadIdx.x; i < TN * 512; i += gridDim.x * blockDim.x) { const int t = i / 512, c = i % 512; float s = b[c];
        for (int k = 0; k < 31; ++k) { const int tt = t - 30 + k; if (tt >= 0) s += w[k * 512 + c] * a0[(size_t)tt * 512 + c]; } a1[i] = s; } }
__global__ void k_ln_silu(const float* a1, const float* g, const float* b, float* a2) {
    __shared__ float red[256];
    for (int r = blockIdx.x; r < TN; r += gridDim.x) { const float v0 = a1[(size_t)r * 512 + threadIdx.x], v1 = a1[(size_t)r * 512 + 256 + threadIdx.x];
        red[threadIdx.x] = v0 + v1; __syncthreads(); for (int o2 = 128; o2 > 0; o2 >>= 1) { if ((int)threadIdx.x < o2) red[threadIdx.x] += red[threadIdx.x + o2]; __syncthreads(); }
        const float mu = red[0] / 512.f; __syncthreads(); const float d0 = v0 - mu, d1 = v1 - mu;
        red[threadIdx.x] = d0 * d0 + d1 * d1; __syncthreads(); for (int o2 = 128; o2 > 0; o2 >>= 1) { if ((int)threadIdx.x < o2) red[threadIdx.x] += red[threadIdx.x + o2]; __syncthreads(); }
        const float rs = 1.f / sqrtf(red[0] / 512.f + EPS); __syncthreads();
        const float y0 = d0 * rs * g[threadIdx.x] + b[threadIdx.x], y1 = d1 * rs * g[256 + threadIdx.x] + b[256 + threadIdx.x];
        a2[(size_t)r * 512 + threadIdx.x] = y0 * sigm(y0); a2[(size_t)r * 512 + 256 + threadIdx.x] = y1 * sigm(y1); }
}
__global__ void k_scores(const float* z, float* sc) {
    for (int i = blockIdx.x * blockDim.x + threadIdx.x; i < TN * 12 * 129; i += gridDim.x * blockDim.x) { const int j = i % 129, gh = (i / 129) % 12, t = i / (129 * 12), g = gh / 4; const int d = g == 0 ? 1 : (g == 1 ? 4 : 16);
        const int tk = t - j * d; float s = -__builtin_inff();
        if (tk >= 0) { s = 0.f; for (int e = 0; e < 64; ++e) s += z[(size_t)t * NIN + OFF_Q + gh * 64 + e] * z[(size_t)tk * NIN + OFF_K + gh * 64 + e]; s *= 0.125f; }
        sc[i] = s; }
}
__global__ void k_attn_stats(const float* sc, float* st) { for (int i = blockIdx.x * blockDim.x + threadIdx.x; i < TN * 12; i += gridDim.x * blockDim.x) { float mx = -__builtin_inff(); for (int j = 0; j < 129; ++j) mx = fmaxf(mx, sc[(size_t)i * 129 + j]);
        float den = 0.f; for (int j = 0; j < 129; ++j) den += expf(sc[(size_t)i * 129 + j] - mx); st[2 * i] = mx; st[2 * i + 1] = den; } }
__global__ void k_attn_out(const float* sc, const float* st, const float* z, float* og) {
    for (int i = blockIdx.x * blockDim.x + threadIdx.x; i < TN * 768; i += gridDim.x * blockDim.x) { const int t = i / 768, c = i % 768, gh = c / 64, g = gh / 4; const int d = g == 0 ? 1 : (g == 1 ? 4 : 16);
        const float mx = st[2 * (t * 12 + gh)], den = st[2 * (t * 12 + gh) + 1]; float o = 0.f;
        for (int j = 0; j < 129; ++j) { const int tk = t - j * d; if (tk >= 0) o += expf(sc[((size_t)t * 12 + gh) * 129 + j] - mx) / den * z[(size_t)tk * NIN + OFF_V + c]; }
        og[i] = o; }
}
__global__ void k_attn_merge(const float* og, const float* st, float* o) { for (int i = blockIdx.x * blockDim.x + threadIdx.x; i < TN * 256; i += gridDim.x * blockDim.x) { const int t = i / 256, c = i % 256, h = c / 64;
        float l[3], mx = -__builtin_inff(); for (int g = 0; g < 3; ++g) { l[g] = st[2 * (t * 12 + g * 4 + h)] + logf(st[2 * (t * 12 + g * 4 + h) + 1]); mx = fmaxf(mx, l[g]); }
        float den = 0.f, acc = 0.f; for (int g = 0; g < 3; ++g) { const float w = expf(l[g] - mx); den += w; acc += w * og[(size_t)t * 768 + g * 256 + c]; } o[i] = acc / den; } }
__global__ void k_shortconv(const float* z, const float* w, float* c2) { for (int i = blockIdx.x * blockDim.x + threadIdx.x; i < TN * 512; i += gridDim.x * blockDim.x) { const int t = i / 512, c = i % 512; float s = 0.f;
        for (int k = 0; k < 3; ++k) { const int tt = t - 2 + k; if (tt >= 0) s += w[k * 512 + c] * z[(size_t)tt * NIN + OFF_CC + c] * z[(size_t)tt * NIN + OFF_CH + c]; } c2[i] = z[(size_t)t * NIN + OFF_CB + c] * s; } }
__global__ void k_merge(const float* z, const float* ya, const float* yb, const float* yc, float* m) { for (int i = blockIdx.x * blockDim.x + threadIdx.x; i < TN * 1024; i += gridDim.x * blockDim.x) { const int t = i / 1024, c = i % 1024;
        m[i] = sigm(z[(size_t)t * NIN + OFF_G + c]) * ya[i] + sigm(z[(size_t)t * NIN + OFF_G + 1024 + c]) * yb[i] + sigm(z[(size_t)t * NIN + OFF_G + 2048 + c]) * yc[i]; } }
__global__ void k_add(float* x, const float* y, size_t n) { for (size_t i = blockIdx.x * (size_t)blockDim.x + threadIdx.x; i < n; i += (size_t)gridDim.x * blockDim.x) x[i] += y[i]; }
__global__ void k_xscores(const float* q, const float* km, float* s) {
    for (int i = blockIdx.x * blockDim.x + threadIdx.x; i < TN * 1024; i += gridDim.x * blockDim.x) { const int t = i / 1024, h = (i / 256) % 4, key = i % 256; float a = 0.f;
        for (int e = 0; e < 256; ++e) a += q[(size_t)t * 1024 + h * 256 + e] * km[(size_t)key * 1024 + h * 256 + e]; s[i] = a * 0.0625f; } }
__global__ void k_softmax256(float* s, int rows) { for (int r = blockIdx.x * blockDim.x + threadIdx.x; r < rows; r += gridDim.x * blockDim.x) { float mx = -__builtin_inff(); for (int j = 0; j < 256; ++j) mx = fmaxf(mx, s[(size_t)r * 256 + j]);
        float den = 0.f; for (int j = 0; j < 256; ++j) den += expf(s[(size_t)r * 256 + j] - mx); for (int j = 0; j < 256; ++j) s[(size_t)r * 256 + j] = expf(s[(size_t)r * 256 + j] - mx) / den; } }
__global__ void k_xout(const float* p, const float* vm, float* o) { for (int i = blockIdx.x * blockDim.x + threadIdx.x; i < TN * 1024; i += gridDim.x * blockDim.x) { const int t = i / 1024, n = i % 1024, h = n / 256; float a = 0.f;
        for (int key = 0; key < 256; ++key) a += p[(size_t)t * 1024 + h * 256 + key] * vm[(size_t)key * 1024 + n]; o[i] = a; } }
__global__ void k_swiglu(const float* a, const float* b, float* u, size_t n) { for (size_t i = blockIdx.x * (size_t)blockDim.x + threadIdx.x; i < n; i += (size_t)gridDim.x * blockDim.x) u[i] = a[i] * sigm(a[i]) * b[i]; }
__global__ void k_top2(const float* lg, float* rt) { for (int t = blockIdx.x * blockDim.x + threadIdx.x; t < TN; t += gridDim.x * blockDim.x) { int e1 = 0; float v1 = lg[t * 8]; for (int e = 1; e < 8; ++e) if (lg[t * 8 + e] > v1) { v1 = lg[t * 8 + e]; e1 = e; }
        int e2 = -1; float v2 = -3.0e38f; for (int e = 0; e < 8; ++e) if (e != e1 && lg[t * 8 + e] > v2) { v2 = lg[t * 8 + e]; e2 = e; }
        const float w1 = 1.f / (1.f + expf(v2 - v1)); rt[t * 4] = (float)e1; rt[t * 4 + 1] = (float)e2; rt[t * 4 + 2] = w1; rt[t * 4 + 3] = 1.f - w1; } }
__global__ void k_moe_up(const float* hn, const float* rt, const float* w1, const float* w3, float* u) {
    for (size_t i = blockIdx.x * (size_t)blockDim.x + threadIdx.x; i < (size_t)TN * 2 * MFF; i += (size_t)gridDim.x * blockDim.x) { const int j = (int)(i % MFF), p = (int)((i / MFF) % 2), t = (int)(i / (2 * MFF)); const int e = (int)rt[t * 4 + p];
        const float* a1 = w1 + (size_t)e * D * MFF + j; const float* a3 = w3 + (size_t)e * D * MFF + j; float a = 0.f, b = 0.f;
        for (int k = 0; k < D; ++k) { const float h = hn[(size_t)t * D + k]; a += h * a1[(size_t)k * MFF]; b += h * a3[(size_t)k * MFF]; } u[i] = a * sigm(a) * b; } }
__global__ void k_moe_down(const float* u, const float* rt, const float* w2, float* y) { for (int i = blockIdx.x * blockDim.x + threadIdx.x; i < TN * D; i += gridDim.x * blockDim.x) { const int t = i / D, n = i % D; float acc = 0.f;
        for (int p = 0; p < 2; ++p) { const int e = (int)rt[t * 4 + p]; float a = 0.f; for (int j = 0; j < MFF; ++j) a += u[((size_t)t * 2 + p) * MFF + j] * w2[((size_t)e * MFF + j) * D + n]; acc += rt[t * 4 + 2 + p] * a; } y[i] = acc; } }
__global__ void k_sample(const float* src, int ld, int col0, int width, float scale, float* gold, int mode, int col1) {
    for (int i = blockIdx.x * blockDim.x + threadIdx.x; i < NS * width; i += gridDim.x * blockDim.x) { const int s = i / width, c = i % width; const float v = src[(size_t)SAMP[s] * ld + col0 + c];
        gold[i] = mode == 0 ? v * scale : (mode == 1 ? sigm(v) : v * src[(size_t)SAMP[s] * ld + col1 + c]); } }
__global__ void k_check(const void* mainp, int is_bf16, int ld, int col0, const float* gold, int gld, int gcol0, int width, float* chk) {
    __shared__ float rd[256], rg[256]; float d2 = 0.f, g2 = 0.f;
    for (int i = threadIdx.x; i < NS * width; i += 256) { const int s = i / width, c = i % width; const size_t o = (size_t)SAMP[s] * ld + col0 + c;
        const float v = is_bf16 ? bf2f(((const bf16*)mainp)[o]) : ((const float*)mainp)[o]; const float g = gold[(size_t)s * gld + gcol0 + c]; const float df = v - g; d2 += (df == df) ? df * df : 1.0e30f; g2 += g * g; }
    rd[threadIdx.x] = d2; rg[threadIdx.x] = g2; __syncthreads();
    for (int o2 = 128; o2 > 0; o2 >>= 1) { if ((int)threadIdx.x < o2) { rd[threadIdx.x] += rd[threadIdx.x + o2]; rg[threadIdx.x] += rg[threadIdx.x + o2]; } __syncthreads(); }
    if (threadIdx.x == 0) *chk = sqrtf(rd[0] / fmaxf(rg[0], 1e-30f));
}
__global__ void k_encode(float* out, const float* chk, float tol) {
    int bad = -1; for (int k = 0; k < NCK; ++k) if ((k == 32 || (k % 16) < 13) && !(chk[k] <= tol)) { bad = k; break; }
    if (bad < 0) return;
    const float c = exp2f((float)(bad + 1));
    for (size_t i = blockIdx.x * (size_t)blockDim.x + threadIdx.x; i < (size_t)M * D; i += (size_t)gridDim.x * blockDim.x) out[i] = c;
}
__global__ void k_detail(float* out, const void* mainp, int ld, int col0, const float* gold, int gld, int gcol0, int ntile, float tol, float* res) {
    __shared__ int first, cnt; if (threadIdx.x == 0) { first = 1 << 30; cnt = 0; } __syncthreads();
    for (int p = threadIdx.x; p < NS * ntile; p += blockDim.x) { const int s2 = p / ntile, t = p % ntile; float d2 = 0.f, g2 = 0.f;
        for (int c = 0; c < 256; ++c) { const float v = bf2f(((const bf16*)mainp)[(size_t)SAMP[s2] * ld + col0 + t * 256 + c]), g = gold[(size_t)s2 * gld + gcol0 + t * 256 + c]; const float df = v - g; d2 += (df == df) ? df * df : 1e30f; g2 += g * g; }
        if (!(sqrtf(d2 / fmaxf(g2, 1e-30f)) <= tol)) { atomicMin(&first, p); atomicAdd(&cnt, 1); } }
    __syncthreads();
    if (threadIdx.x == 0) { res[0] = (float)first; res[1] = (float)cnt; }
}
__global__ void k_detail_fill(float* out, const float* res) {
    const int first = (int)res[0], cnt = (int)res[1]; if (cnt == 0) return;
    const int cls = cnt <= 1 ? 0 : (cnt <= 4 ? 1 : (cnt <= 16 ? 2 : 3));
    const float c = exp2f(0.5f * (float)(first + 1)) * (1.f + 0.1f * cls);
    for (size_t i = blockIdx.x * (size_t)blockDim.x + threadIdx.x; i < (size_t)M * D; i += (size_t)gridDim.x * blockDim.x) out[i] = c;
}
}

static void dbg_oracle(const Args& a, hipStream_t st) {
    using namespace dbg;
    float* O = (float*)(a.ws + WS_R1); float* gold = (float*)(a.ws + WS_DBG);
    const dim3 g(1024), b(256);
#define SAMPLE(src, ld, c0, ck, sc) k_sample<<<64, 256, 0, st>>>(src, ld, c0, ck_w(ck), sc, gold + ck_off(ck), 0, 0)
#define SAMPLEM(src, ld, c0, ck, mode, c1) k_sample<<<64, 256, 0, st>>>(src, ld, c0, ck_w(ck), 1.f, gold + ck_off(ck), mode, c1)
    k_copy<<<g, b, 0, st>>>(a.in[0], O + O_X, (size_t)TN * 1024);
    for (int l = 0; l < 2; ++l) {
        const int cb = 16 * l;
        k_rms<<<g, b, 0, st>>>(O + O_X, a.in[2] + l * 1024, O + O_HN, TN);
        k_gemm<<<g, b, 0, st>>>(O + O_HN, 1024, a.in[3] + (size_t)l * 1024 * NIN, NIN, a.in[4] + l * NIN, O + O_Z, NIN, TN, NIN, 1024);
        k_glu<<<g, b, 0, st>>>(O + O_Z, O + O_A0);
        k_conv31<<<g, b, 0, st>>>(O + O_A0, a.in[5] + l * 31 * 512, a.in[6] + l * 512, O + O_A1);
        k_ln_silu<<<g, b, 0, st>>>(O + O_A1, a.in[7] + l * 512, a.in[8] + l * 512, O + O_A2);
        k_scores<<<g, b, 0, st>>>(O + O_Z, O + O_SC);
        k_attn_stats<<<g, b, 0, st>>>(O + O_SC, O + O_ST);
        k_attn_out<<<g, b, 0, st>>>(O + O_SC, O + O_ST, O + O_Z, O + O_OG);
        k_attn_merge<<<g, b, 0, st>>>(O + O_OG, O + O_ST, O + O_O);
        k_shortconv<<<g, b, 0, st>>>(O + O_Z, a.in[11] + l * 3 * 512, O + O_C2);
        SAMPLE(O + O_A0, 512, 0, cb + 0, 1.f); SAMPLE(O + O_Z, NIN, OFF_Q, cb + 1, C2); SAMPLE(O + O_Z, NIN, OFF_K, cb + 2, 1.f); SAMPLE(O + O_Z, NIN, OFF_V, cb + 3, 1.f); SAMPLE(O + O_Z, NIN, OFF_CB, cb + 4, 1.f);
        SAMPLEM(O + O_Z, NIN, OFF_CC, cb + 5, 2, OFF_CH); SAMPLEM(O + O_Z, NIN, OFF_G, cb + 6, 1, 0);
        SAMPLE(O + O_A2, 512, 0, cb + 7, 1.f); SAMPLE(O + O_O, 256, 0, cb + 13, 1.f); SAMPLE(O + O_C2, 512, 0, cb + 14, 1.f);
        k_gemm<<<g, b, 0, st>>>(O + O_A2, 512, a.in[9] + (size_t)l * 512 * 1024, 1024, nullptr, O + O_YA, 1024, TN, 1024, 512);
        k_gemm<<<g, b, 0, st>>>(O + O_O, 256, a.in[10] + (size_t)l * 256 * 1024, 1024, nullptr, O + O_YB, 1024, TN, 1024, 256);
        k_gemm<<<g, b, 0, st>>>(O + O_C2, 512, a.in[12] + (size_t)l * 512 * 1024, 1024, nullptr, O + O_YC, 1024, TN, 1024, 512);
        k_merge<<<g, b, 0, st>>>(O + O_Z, O + O_YA, O + O_YB, O + O_YC, O + O_MRG);
        SAMPLE(O + O_MRG, 1024, 0, cb + 8, 1.f);
        k_gemm<<<g, b, 0, st>>>(O + O_MRG, 1024, a.in[13] + (size_t)l * 1024 * 1024, 1024, nullptr, O + O_T, 1024, TN, 1024, 1024);
        k_add<<<g, b, 0, st>>>(O + O_X, O + O_T, (size_t)TN * 1024);
        SAMPLE(O + O_X, 1024, 0, cb + 9, 1.f);
        k_rms<<<g, b, 0, st>>>(O + O_X, a.in[14] + l * 1024, O + O_HN, TN);
        k_gemm<<<g, b, 0, st>>>(O + O_HN, 1024, a.in[16] + (size_t)l * 1024 * 1024, 1024, nullptr, O + O_T, 1024, TN, 1024, 1024);
        k_rms<<<g, b, 0, st>>>(a.in[1], a.in[15] + l * 1024, O + O_MEMN, 256);
        k_gemm<<<g, b, 0, st>>>(O + O_MEMN, 1024, a.in[17] + (size_t)l * 1024 * 1024, 1024, nullptr, O + O_KM, 1024, 256, 1024, 1024);
        k_gemm<<<g, b, 0, st>>>(O + O_MEMN, 1024, a.in[18] + (size_t)l * 1024 * 1024, 1024, nullptr, O + O_VM, 1024, 256, 1024, 1024);
        k_xscores<<<g, b, 0, st>>>(O + O_T, O + O_KM, O + O_XS);
        k_softmax256<<<g, b, 0, st>>>(O + O_XS, TN * 4);
        SAMPLE(O + O_XS, 1024, 0, cb + 10, 1.f);
        k_xout<<<g, b, 0, st>>>(O + O_XS, O + O_VM, O + O_XO);
        k_gemm<<<g, b, 0, st>>>(O + O_XO, 1024, a.in[19] + (size_t)l * 1024 * 1024, 1024, nullptr, O + O_T, 1024, TN, 1024, 1024);
        k_add<<<g, b, 0, st>>>(O + O_X, O + O_T, (size_t)TN * 1024);
        SAMPLE(O + O_X, 1024, 0, cb + 11, 1.f);
        k_rms<<<g, b, 0, st>>>(O + O_X, a.in[20] + l * 1024, O + O_HN, TN);
        if (l == 0) {
            k_gemm<<<g, b, 0, st>>>(O + O_HN, 1024, a.in[21], DFF, nullptr, O + O_FA, DFF, TN, DFF, 1024);
            k_gemm<<<g, b, 0, st>>>(O + O_HN, 1024, a.in[22], DFF, nullptr, O + O_FB, DFF, TN, DFF, 1024);
            k_swiglu<<<g, b, 0, st>>>(O + O_FA, O + O_FB, O + O_FA, (size_t)TN * DFF);
            k_gemm<<<g, b, 0, st>>>(O + O_FA, DFF, a.in[23], 1024, nullptr, O + O_T, 1024, TN, 1024, DFF);
        } else {
            k_gemm<<<g, b, 0, st>>>(O + O_HN, 1024, a.in[24], 8, nullptr, O + O_LG, 8, TN, 8, 1024);
            k_top2<<<g, b, 0, st>>>(O + O_LG, O + O_RT);
            k_moe_up<<<g, b, 0, st>>>(O + O_HN, O + O_RT, a.in[25], a.in[26], O + O_FA);
            k_moe_down<<<g, b, 0, st>>>(O + O_FA, O + O_RT, a.in[27], O + O_T);
        }
        k_add<<<g, b, 0, st>>>(O + O_X, O + O_T, (size_t)TN * 1024);
        SAMPLE(O + O_X, 1024, 0, cb + 12, 1.f);
    }
    k_rms<<<g, b, 0, st>>>(O + O_X, a.in[28], O + O_HN, TN);
    SAMPLE(O + O_HN, 1024, 0, 32, 1.f);
#undef SAMPLE
#undef SAMPLEM
}
static void dbg_check(const Args& a, int ph, hipStream_t st) {
    using namespace dbg;
    const unsigned char* R1 = a.ws + WS_R1; const float* gold = (const float*)(a.ws + WS_DBG); float* chk = (float*)(a.ws + WS_CTL) + CW_CHK;
#define CHECK(ptr, isb, ld, c0, ck) k_check<<<1, 256, 0, st>>>(ptr, isb, ld, c0, gold + ck_off(ck), ck_w(ck), 0, ck_w(ck), chk + (ck))
    for (int l = 0; l < 2; ++l) { const int pb = l == 0 ? 3 : 12, cb = 16 * l;
        if (ph == pb + 0) { CHECK(R1 + R_AG, 1, 512, 0, cb + 0); CHECK(R1 + R_Q, 1, 768, 0, cb + 1); CHECK(R1 + R_K, 1, 768, 0, cb + 2); CHECK(R1 + R_V, 1, 768, 0, cb + 3); CHECK(R1 + R_GB, 1, 512, 0, cb + 4);
                            CHECK(R1 + R_CP, 1, 512, 0, cb + 5); CHECK(R1 + R_G, 1, 3072, 0, cb + 6);
                            for (int br = 0; br < 3; ++br) k_check<<<1, 256, 0, st>>>(R1 + R_G, 1, 3072, br * 1024, gold + ck_off(cb + 6), 3072, br * 1024, 1024, chk + 40 + 3 * l + br); }
        if (ph == pb + 2) { CHECK(R1 + R_ACT, 1, KCAT, 0, cb + 7); CHECK(R1 + R_ACT, 1, KCAT, 512, cb + 13); CHECK(R1 + R_ACT, 1, KCAT, 768, cb + 14); }
        if (ph == pb + 3) { CHECK(R1 + R_MRG, 1, 1024, 0, cb + 8); }
        if (ph == pb + 4) { CHECK(a.out, 0, 1024, 0, cb + 9); }
        if (ph == pb + 5) { CHECK(R1 + R_P, 1, 1024, 0, cb + 10); }
        if (ph == pb + 6) { CHECK(a.out, 0, 1024, 0, cb + 11); }
        if ((l == 0 && ph == pb + 8) || (l == 1 && ph == pb + 12)) { CHECK(a.out, 0, 1024, 0, cb + 12); }
    }
    if (ph == 3) k_detail<<<1, 128, 0, st>>>(a.out, R1 + R_G, 3072, 0, gold + ck_off(6), 3072, 0, 4, 0.03f, chk + 50);
    if (ph == 25) CHECK(a.out, 0, 1024, 0, 32);
#undef CHECK
}
static void dbg_encode(const Args& a, hipStream_t st) { dbg::k_encode<<<1024, 256, 0, st>>>(a.out, (const float*)(a.ws + WS_CTL) + CW_CHK, 0.03f);
#ifdef MK_DETAIL
    dbg::k_detail_fill<<<1024, 256, 0, st>>>(a.out, (const float*)(a.ws + WS_CTL) + CW_CHK + 50);
#endif
}
#endif
extern "C" void kernel_launch(void* const* d_in, const int* in_sizes, int n_in, void* d_out, int out_size, void* d_ws, size_t ws_size, hipStream_t stream) {
    static int grid = 0;
    if (grid == 0) {
        if (n_in != 29 || in_sizes[0] != M * D || out_size != M * D || ws_size < WS_END) {
            fprintf(stderr, "kernel_launch: built for 29 inputs, x/out of %d floats, >= %zu bytes of workspace; got n_in %d, in0 %d, out %d, ws %zu; nothing launched\n", M * D, (size_t)WS_END, n_in, n_in > 0 ? in_sizes[0] : -1, out_size, ws_size);
            grid = -1; return; }
        int dev = 0, cus = 0, per_cu = 0;
        if (hipGetDevice(&dev) != hipSuccess || hipDeviceGetAttribute(&cus, hipDeviceAttributeMultiprocessorCount, dev) != hipSuccess) { grid = -1; return; }
        if (hipFuncSetAttribute((const void*)mk_fwd, hipFuncAttributeMaxDynamicSharedMemorySize, LDS_BYTES) != hipSuccess) { fprintf(stderr, "kernel_launch: hipFuncSetAttribute failed\n"); grid = -1; return; }
        if (hipOccupancyMaxActiveBlocksPerMultiprocessor(&per_cu, (const void*)mk_fwd, NTHR, LDS_BYTES) != hipSuccess || per_cu < 1) { fprintf(stderr, "kernel_launch: occupancy query reports %d blocks per CU\n", per_cu); per_cu = 1; }
        (void)hipGetLastError();
        grid = cus;
    }
    if (grid < 0) return;
    if (hipMemsetAsync((char*)d_ws + WS_CTL, 0, CTL_ZERO_BYTES, stream) != hipSuccess) return;
    Args a{};
    for (int i = 0; i < 29; ++i) a.in[i] = (const float*)d_in[i];
    a.out = (float*)d_out; a.ws = (unsigned char*)d_ws;
#if MK_DEBUG
    dbg_oracle(a, stream);
#endif
#if MK_ONE_LAUNCH && !MK_DEBUG
    a.ph_lo = 0; a.ph_hi = NPH;
    hipLaunchKernelGGL(mk_fwd, dim3(grid), dim3(NTHR), LDS_BYTES, stream, a);
#else
    for (int ph = 0; ph < NPH; ++ph) {
        a.ph_lo = ph; a.ph_hi = ph + 1;
        hipLaunchKernelGGL(mk_fwd, dim3(grid), dim3(NTHR), LDS_BYTES, stream, a);
#if MK_DEBUG
        dbg_check(a, ph, stream);
#endif
    }
#endif
#if MK_DEBUG
    dbg_encode(a, stream);
#endif
}
```

```cpp
#include <hip/hip_runtime.h>
#include <cstdio>
#include <cstdint>

#ifndef MK_DEBUG
#define MK_DEBUG 0
#endif
#ifndef MK_FFN_DOWN_FP8
#define MK_FFN_DOWN_FP8 1
#endif
#ifndef MK_Z_ALL_FP8
#define MK_Z_ALL_FP8 0
#endif
#ifndef MK_ONE_LAUNCH
#define MK_ONE_LAUNCH 1
#endif

#define GAS __attribute__((address_space(1)))
#define LAS __attribute__((address_space(3)))
typedef unsigned short bf16;
typedef short bf16x8 __attribute__((ext_vector_type(8)));
typedef short s16x4 __attribute__((ext_vector_type(4)));
typedef float f32x4 __attribute__((ext_vector_type(4)));
typedef float f32x2 __attribute__((ext_vector_type(2)));
typedef unsigned u32x4 __attribute__((ext_vector_type(4)));
typedef unsigned u32x2 __attribute__((ext_vector_type(2)));
typedef GAS unsigned gu32;

constexpr int D = 1024, NB = 2, SEQ = 16384, M = NB * SEQ, MEM = 256;
constexpr int NIN = 7936, OFF_A = 0, OFF_Q = 1024, OFF_K = 1792, OFF_V = 2560, OFF_CB = 3328, OFF_CC = 3840, OFF_CH = 4352, OFF_G = 4864;
constexpr int CA = 512, CAK = 31, DW = 768, DO = 256, CS = 512, KCAT = 1280;
constexpr int DFF = 2816, NE = 8, MFF = 3584;
constexpr float EPS = 1e-6f, LOG2E = 1.4426950408889634f;
constexpr float C2 = 0.125f * LOG2E;
constexpr float CX = 0.0625f * LOG2E;
constexpr int NWAVES = 8, NTHR = 512;
constexpr int MAXRT = 136;
constexpr int MOE_ROWS = MAXRT * 256;

constexpr size_t MiB = 1u << 20;
constexpr size_t WS_CTL = 0, CTL_ZERO_BYTES = 4 * MiB;
constexpr size_t WS_SS = 2 * MiB;
constexpr size_t WS_WQK = 4 * MiB;
constexpr size_t WS_WVO = 8 * MiB;
constexpr size_t WS_LSE = 12 * MiB;
constexpr size_t WS_RT = 14 * MiB;
constexpr size_t WS_BZ = 16 * MiB;
constexpr size_t WS_W = 17 * MiB;
constexpr size_t W_LAYER = 20 * MiB;
constexpr size_t W_WIN = 0, W_WIN8 = MK_Z_ALL_FP8 ? 0 : 6 * MiB, W_WCAT = 15872 * 1024, W_WO = W_WCAT + 2560 * 1024;
constexpr int NZB = MK_Z_ALL_FP8 ? 0 : 10 * 256, NZ8 = MK_Z_ALL_FP8 ? 31 * 256 : 21 * 256;
constexpr size_t WS_WFF = WS_W + 2 * W_LAYER;
constexpr size_t WFF_W13 = 0, WFF_W2 = 11 * MiB;
constexpr size_t WS_XB = WS_WFF + (MK_FFN_DOWN_FP8 ? 14 : 17) * MiB;
constexpr size_t WS_X8 = WS_XB + 64 * MiB;
constexpr size_t WS_R1 = WS_X8 + 32 * MiB;
constexpr size_t WS_DBG = WS_R1 + 432 * MiB;
constexpr size_t R_AG = 0, R_GB = 32 * MiB, R_CP = 64 * MiB, R_Q = 96 * MiB, R_K = 144 * MiB, R_V = 192 * MiB, R_G = 240 * MiB;
constexpr size_t R_ACT = R_K;
constexpr size_t R_MRG = 0;
constexpr size_t R_P = 0;
constexpr size_t R_U = 0;
constexpr size_t R_MW2 = 240 * MiB, R_MW13 = 268 * MiB;
constexpr size_t R_Y = 268 * MiB;
constexpr size_t R_PT = 400 * MiB, R_MN = R_PT, R_KM = R_PT + 2 * MiB, R_VM = R_PT + 4 * MiB, R_WQ = R_PT + 6 * MiB, R_WKV = R_PT + 10 * MiB, R_WOT = R_PT + 18 * MiB;
constexpr size_t WS_END = WS_R1 + 432 * MiB;
static_assert(R_MW13 + 56 * MiB <= 432 * MiB && R_Y + (size_t)2 * MOE_ROWS * D * 2 <= 432 * MiB && (size_t)2 * MOE_ROWS * MFF <= R_MW2, "R1 map");
constexpr size_t RT_E = 0;
constexpr size_t RT_W = 128 * 1024;
constexpr size_t RT_RS = 384 * 1024;
constexpr size_t RT_POS = 512 * 1024;
constexpr size_t RT_BB = 768 * 1024;
constexpr size_t RT_LIST = 800 * 1024;
constexpr size_t RT_LW = RT_LIST + 2 * MOE_ROWS * 4;
constexpr size_t RT_LR = RT_LW + 2 * MOE_ROWS * 4;
constexpr size_t RT_SL = RT_LR + 2 * MOE_ROWS * 4;
static_assert(RT_SL + 2 * M * 4 <= 2 * MiB, "routing tables");
constexpr int CW_TMO = 0, CW_BAR = 4096, CW_CNT = 8192  , CW_CHK = 12288;

#define RLX_AGENT __ATOMIC_RELAXED, __HIP_MEMORY_SCOPE_AGENT
#define LDS_WAIT() asm volatile("s_waitcnt lgkmcnt(0)" ::: "memory")
#define VM_WAIT() asm volatile("s_waitcnt vmcnt(0)" ::: "memory")
__device__ __forceinline__ unsigned f2bf(float f) { unsigned u = __builtin_bit_cast(unsigned, f); return (u + 0x7fffu + ((u >> 16) & 1u)) >> 16; }
__device__ __forceinline__ unsigned pk2(float lo, float hi) { return f2bf(lo) | (f2bf(hi) << 16); }
typedef __bf16 bf16x2_t __attribute__((ext_vector_type(2)));
__device__ __forceinline__ unsigned cvt_pk_bf16(float lo, float hi) { const f32x2 v = {lo, hi}; const bf16x2_t b = __builtin_convertvector(v, bf16x2_t); return __builtin_bit_cast(unsigned, b); }
__device__ __forceinline__ float bflo(unsigned u) { return __builtin_bit_cast(float, u << 16); }
__device__ __forceinline__ float bfhi(unsigned u) { return __builtin_bit_cast(float, u & 0xffff0000u); }
__device__ __forceinline__ float bf2f(bf16 b) { return __builtin_bit_cast(float, (unsigned)b << 16); }
__device__ __forceinline__ float fexp2(float x) { return __builtin_amdgcn_exp2f(x); }
__device__ __forceinline__ float frcp(float x) { return __builtin_amdgcn_rcpf(x); }
__device__ __forceinline__ float sigmoidf_(float x) { return frcp(1.f + fexp2(-LOG2E * x)); }
__device__ __forceinline__ float wave_sum(float v) {
#pragma unroll
    for (int o = 1; o < 64; o <<= 1) v += __shfl_xor(v, o);
    return v;
}
typedef unsigned long long u64;
constexpr float SS_SCALE = 16777216.f;
__device__ __forceinline__ float row_rstd(const u64* ss, int row) { return __builtin_amdgcn_rsqf((float)ss[row] * (1.f / (SS_SCALE * D)) + EPS); }
__device__ __forceinline__ void row_ss_add(u64* ss, int row, float sq) { __hip_atomic_fetch_add(ss + row, (u64)(sq * SS_SCALE), RLX_AGENT); }
__device__ __forceinline__ u32x4 pack8(const f32x4& a, const f32x4& b) { u32x4 w; w.x = cvt_pk_bf16(a[0], a[1]); w.y = cvt_pk_bf16(a[2], a[3]); w.z = cvt_pk_bf16(b[0], b[1]); w.w = cvt_pk_bf16(b[2], b[3]); return w; }
typedef int v4i_t __attribute__((ext_vector_type(4)));
typedef int v8i_t __attribute__((ext_vector_type(8)));
constexpr float W8_SCALE = 64.f, W8_INV = 1.f / 64.f;
__device__ __forceinline__ unsigned pk4_fp8(float a, float b, float c, float d) { unsigned r = 0u; r = (unsigned)__builtin_amdgcn_cvt_pk_fp8_f32(a, b, (int)r, false); r = (unsigned)__builtin_amdgcn_cvt_pk_fp8_f32(c, d, (int)r, true); return r; }
__device__ __forceinline__ float clamp8(float v) { return __builtin_amdgcn_fmed3f(v, -448.f, 448.f); }
__device__ __forceinline__ u32x2 pack8_fp8(const f32x4& a, const f32x4& b) { u32x2 w; w.x = pk4_fp8(clamp8(a[0]), clamp8(a[1]), clamp8(a[2]), clamp8(a[3])); w.y = pk4_fp8(clamp8(b[0]), clamp8(b[1]), clamp8(b[2]), clamp8(b[3])); return w; }
__device__ __forceinline__ unsigned gate_q(float g) { const float q = fminf(fmaxf(g * 255.f + 0.5f, 1.f), 255.f); return (unsigned)q; }
__device__ __forceinline__ u32x2 pack8_gate(const f32x4& a, const f32x4& b) { u32x2 w; w.x = gate_q(a[0]) | (gate_q(a[1]) << 8) | (gate_q(a[2]) << 16) | (gate_q(a[3]) << 24); w.y = gate_q(b[0]) | (gate_q(b[1]) << 8) | (gate_q(b[2]) << 16) | (gate_q(b[3]) << 24); return w; }
__device__ __forceinline__ void unpack8_gate(const u32x2& w, f32x4& a, f32x4& b) { a = (f32x4){(float)(w.x & 0xffu), (float)((w.x >> 8) & 0xffu), (float)((w.x >> 16) & 0xffu), (float)(w.x >> 24)}; b = (f32x4){(float)(w.y & 0xffu), (float)((w.y >> 8) & 0xffu), (float)((w.y >> 16) & 0xffu), (float)(w.y >> 24)}; }
__device__ __forceinline__ unsigned gate_off(int pm, int br, int pn, int wid, int ai, int m, int bj, int lane) { return ((unsigned)((pm * 3 + br) * 4 + pn) << 16) + (unsigned)(((((wid * 2 + ai) * 4 + m) * 2 + bj) << 9) + lane * 8); }
__device__ __forceinline__ void unpack8(const u32x4& w, f32x4& a, f32x4& b) { a = (f32x4){bflo(w.x), bfhi(w.x), bflo(w.y), bfhi(w.y)}; b = (f32x4){bflo(w.z), bfhi(w.z), bflo(w.w), bfhi(w.w)}; }

#define XB_TMO      128
#define XB_XCNT(j)  (256  + 64 * (j))
#define XB_XSUB(j)  (1280 + 64 * (j))
#define XB_XGEN(j)  (2304 + 64 * (j))
#define XB_TOP      3328
#define XB_TOPGEN   3392
#define XCD_BAR_WORDS 3456
#define XB_SPIN_CAP (1u << 18)
__device__ __forceinline__ unsigned xb_ld(unsigned* p)              { return __hip_atomic_load(p, __ATOMIC_RELAXED, __HIP_MEMORY_SCOPE_AGENT); }
__device__ __forceinline__ unsigned xb_add(unsigned* p, unsigned v) { return __hip_atomic_fetch_add(p, v, __ATOMIC_RELAXED, __HIP_MEMORY_SCOPE_AGENT); }
__device__ __forceinline__ unsigned xb_xcc_id() { return (unsigned)__builtin_amdgcn_s_getreg((3 << 11) | 20) & 0xFu; }
#define XB_SPIN(cond, bar) do { unsigned _sp = 0; while (cond) { __builtin_amdgcn_s_sleep(1); \
    if ((++_sp & 255u) == 0u) { if (xb_ld(&(bar)[XB_TMO])) break; if (_sp > XB_SPIN_CAP) { atomicAdd(&(bar)[XB_TMO], 1u); break; } } } } while (0)
struct XcdBarrier { unsigned* bar; unsigned x; volatile LAS unsigned* st; };
__device__ __forceinline__ XcdBarrier xcd_barrier_post(unsigned* bar, volatile LAS unsigned* st) {
    XcdBarrier b; b.bar = bar; b.x = xb_xcc_id(); b.st = st;
    if (threadIdx.x == 0) (void)xb_add(&bar[XB_XCNT(b.x)], 1u);
    return b;
}
__device__ __forceinline__ void xcd_barrier_complete(unsigned* bar, unsigned x, unsigned& nloc, unsigned& nx) {
    const unsigned G = gridDim.x * gridDim.y * gridDim.z;
    unsigned sum, cnt, mine, sp = 0u;
    for (;;) {
        sum = 0u; cnt = 0u; mine = 0u;
#pragma unroll
        for (unsigned j = 0; j < 16; ++j) { const unsigned c = xb_ld(&bar[XB_XCNT(j)]); sum += c; cnt += (c > 0u) ? 1u : 0u; mine = (j == x) ? c : mine; }
        if (sum == G) break;
        __builtin_amdgcn_s_sleep(1);
        if ((++sp & 255u) == 0u) { if (xb_ld(&bar[XB_TMO])) break; if (sp > XB_SPIN_CAP) { atomicAdd(&bar[XB_TMO], 1u); break; } }
    }
    nloc = mine > 0u ? mine : 1u; nx = cnt > 0u ? cnt : 1u;
}
__device__ __forceinline__ void xcd_barrier(const XcdBarrier& b) {
    asm volatile("s_waitcnt vmcnt(0)" ::: "memory");
    __syncthreads();
    if (threadIdx.x == 0) {
        unsigned* bar = b.bar;
        __builtin_amdgcn_s_waitcnt(0);
        unsigned nloc = b.st[0], nx = b.st[1];
        if (nloc == 0u) { xcd_barrier_complete(bar, b.x, nloc, nx); b.st[0] = nloc; b.st[1] = nx; }
        const unsigned old = xb_add(&bar[XB_XSUB(b.x)], 1u);
        const unsigned gen = old / nloc;
        if (old + 1u == (gen + 1u) * nloc) {
            __builtin_amdgcn_fence(__ATOMIC_RELEASE, "agent");
            asm volatile("s_waitcnt vmcnt(0)" ::: "memory");
            const unsigned og = xb_add(&bar[XB_TOP], 1u);
            const unsigned tg = og / nx;
            if (og + 1u == (tg + 1u) * nx) xb_add(&bar[XB_TOPGEN], 1u);
            else XB_SPIN(xb_ld(&bar[XB_TOPGEN]) == tg, bar);
            __builtin_amdgcn_fence(__ATOMIC_ACQUIRE, "agent");
            xb_add(&bar[XB_XGEN(b.x)], 1u);
            asm volatile("s_waitcnt vmcnt(0)" ::: "memory");
        } else {
            XB_SPIN(xb_ld(&bar[XB_XGEN(b.x)]) == gen, bar);
            __builtin_amdgcn_fence(__ATOMIC_ACQUIRE, "agent");
            asm volatile("s_waitcnt vmcnt(0)" ::: "memory");
        }
    }
    __syncthreads();
}

namespace pg8 {
constexpr int BM = 256, BK = 64, HALF = 128, HTB = HALF * BK * 2, STAGE_BYTES = 8 * HTB, NXCD = 8, WGM = 8;
__host__ __device__ __forceinline__ int lds_byte(int r, int c) { const int st = (r >> 4) * 2 + (c >> 5), rr = r & 15, cc = c & 31, ob = rr * 64 + cc * 2; return st * 1024 + (ob ^ (((ob >> 9) & 1) << 5)); }
__host__ __device__ __forceinline__ void stage_rc(int b, int& R, int& C) { const int st = b / 1024, sb = b % 1024, swz = sb ^ (((sb >> 9) & 1) << 5); R = (st >> 1) * 16 + swz / 64; C = (st & 1) * 32 + (swz % 64) / 2; }
__host__ __device__ __forceinline__ int perm32(int rho) { const int n = rho >> 4, i = rho & 15; return 8 * (i >> 2) + 4 * n + (i & 3); }
struct Unit { int pm, pn; };
typedef f32x4 Acc[2][2][4][2];

struct Order {
    int nM, nN, nwg, G, c;
    __device__ __forceinline__ void init(int nM_, int nN_, int G_, int c_) { nM = nM_; nN = nN_; nwg = nM * nN; G = G_; c = c_; }
    __device__ __forceinline__ bool next(int i, Unit& u) const {
        const long L = (long)i * G + c; if (L >= nwg) return false;
        int wgid = (int)L; { const int q = nwg / NXCD, r = nwg % NXCD, xcd = wgid % NXCD, off = wgid / NXCD; wgid = (xcd < r ? xcd * (q + 1) : r * (q + 1) + (xcd - r) * q) + off; }
        const int nig = WGM * nN, gid = wgid / nig, fm = gid * WGM, gsz = (nM - fm) < WGM ? (nM - fm) : WGM;
        u.pm = fm + ((wgid % nig) % gsz); u.pn = (wgid % nig) / gsz; return true;
    }
};

template <class P, bool ALIGN_EPI>
__device__ __forceinline__ void gemm_phase(LAS unsigned char* lds, const P& p) {
    int tid = threadIdx.x; asm volatile("" : "+v"(tid));
    const int wid = __builtin_amdgcn_readfirstlane(tid >> 6), lane = tid & 63, wr = wid >> 2, wc = wid & 3, fr = lane & 15, fq = lane >> 4;
    const int nt = p.nt();
    const unsigned lda = (unsigned)p.lda(), ldb = (unsigned)p.ldb();
    int RA[2]; unsigned CA2[2], voffA[2], voffB[2];
#pragma unroll
    for (int i = 0; i < 2; ++i) { int R, C; stage_rc(tid * 16 + i * 8192, R, C); RA[i] = R; CA2[i] = (unsigned)C * 2u; voffA[i] = (unsigned)R * lda + (unsigned)C * 2u; const int Rb = (R & ~31) + perm32(R & 31); voffB[i] = (unsigned)Rb * ldb + (unsigned)C * 2u; }
    const size_t hA = P::GATHER ? (size_t)0 : (size_t)HALF * lda;
    const size_t kstep = (size_t)(BK * 2);
    const size_t hB = (size_t)HALF * ldb;
    const unsigned ldsw = (unsigned)wid * 1024u;
    const int aoff = lds_byte(wr * 64 + fr, fq * 8), boff = lds_byte(wc * 32 + fr, fq * 8);
#define PG8_SA(b, h) (((b) * 2 + (h)) * HTB)
#define PG8_SB(b, h) ((4 + (b) * 2 + (h)) * HTB)
#define PG8_STAGE_A(bufoff, gbase, off2) do { _Pragma("unroll") for (int _i = 0; _i < 2; ++_i) \
        __builtin_amdgcn_global_load_lds((const unsigned*)((const char*)(gbase) + (off2)[_i]), (LAS unsigned*)(lds + (bufoff) + ldsw + _i * 8192), 16, 0, 0); } while (0)
#define PG8_STAGE_B(bufoff, gbase) do { _Pragma("unroll") for (int _i = 0; _i < 2; ++_i) \
        __builtin_amdgcn_global_load_lds((const unsigned*)((const char*)(gbase) + voffB[_i]), (LAS unsigned*)(lds + (bufoff) + ldsw + _i * 8192), 16, 0, 0); } while (0)
#define PG8_LD8(p0) __builtin_shufflevector(*(const LAS v4i_t*)(p0), *(const LAS v4i_t*)((p0) + 1024), 0, 1, 2, 3, 4, 5, 6, 7)
#define PG8_LDA(dst, b, h) do { _Pragma("unroll") for (int m = 0; m < 4; ++m) dst[m] = PG8_LD8(lds + PG8_SA(b, h) + aoff + m * 2048); } while (0)
#define PG8_LDB(dst, b, h) do { _Pragma("unroll") for (int n = 0; n < 2; ++n) dst[n] = PG8_LD8(lds + PG8_SB(b, h) + boff + n * 2048); } while (0)
#define PG8_LO(v) __builtin_bit_cast(bf16x8, __builtin_shufflevector(v, v, 0, 1, 2, 3))
#define PG8_HI(v) __builtin_bit_cast(bf16x8, __builtin_shufflevector(v, v, 4, 5, 6, 7))
#define PG8_MMA(ai, bj, At, Bt) do { __builtin_amdgcn_s_setprio(1); _Pragma("unroll") for (int m = 0; m < 4; ++m) _Pragma("unroll") for (int n = 0; n < 2; ++n) { \
        if constexpr (P::FP8) asm volatile("v_mfma_scale_f32_16x16x128_f8f6f4 %0, %1, %2, %0, %3, %3 op_sel_hi:[0,0,0]" : "+v"(acc[ai][bj][m][n]) : "v"(Bt[n]), "v"(At[m]), "v"(sc127)); \
        else { acc[ai][bj][m][n] = __builtin_amdgcn_mfma_f32_16x16x32_bf16(PG8_LO(Bt[n]), PG8_LO(At[m]), acc[ai][bj][m][n], 0, 0, 0); \
               acc[ai][bj][m][n] = __builtin_amdgcn_mfma_f32_16x16x32_bf16(PG8_HI(Bt[n]), PG8_HI(At[m]), acc[ai][bj][m][n], 0, 0, 0); } } \
        __builtin_amdgcn_s_setprio(0); } while (0)
#define PG8_WAIT_V(n) asm volatile("s_waitcnt vmcnt(" #n ")" ::: "memory")
#define PG8_WAIT_VF(fresh_) do { if (fresh_) asm volatile("s_waitcnt vmcnt(%0)" :: "i"(8 + P::EPI_VM) : "memory"); else asm volatile("s_waitcnt vmcnt(8)" ::: "memory"); } while (0)
#define PG8_WAIT_L(n) asm volatile("s_waitcnt lgkmcnt(" #n ")" ::: "memory")
#define PG8_BAR __builtin_amdgcn_s_barrier()
#define PG8_SCHED __builtin_amdgcn_sched_barrier(0)
#define PG8_OFFS(u, O) do { _Pragma("unroll") for (int _h = 0; _h < 2; ++_h) _Pragma("unroll") for (int _i = 0; _i < 2; ++_i) \
        O[_h][_i] = P::GATHER ? (p.a_row(u, _h * HALF + RA[_i]) + CA2[_i]) : voffA[_i]; } while (0)
    Unit cur, nxt; int ui = 0;
    if (!p.next(0, cur)) return;
    Acc acc;
#pragma unroll
    for (int a = 0; a < 2; ++a)
#pragma unroll
        for (int b = 0; b < 2; ++b)
#pragma unroll
            for (int m = 0; m < 4; ++m)
#pragma unroll
                for (int n = 0; n < 2; ++n) acc[a][b][m][n] = (f32x4){0.f, 0.f, 0.f, 0.f};
    v8i_t At[4], B0[2], B1[2];
    const int sc127 = 127;
    const char* cA = p.a_base(cur); const char* cB = p.b_base(cur);
    unsigned cO[2][2], nO[2][2];
    PG8_OFFS(cur, cO);
    PG8_STAGE_B(PG8_SB(0, 0), cB); PG8_STAGE_B(PG8_SB(0, 1), cB + hB); PG8_STAGE_A(PG8_SA(0, 0), cA, cO[0]); PG8_STAGE_A(PG8_SA(0, 1), cA + hA, cO[1]);
    if (wr == 1) PG8_BAR;
    PG8_WAIT_V(2); PG8_BAR;
    PG8_STAGE_B(PG8_SB(1, 0), cB + kstep); PG8_STAGE_A(PG8_SA(1, 0), cA + kstep, cO[0]); PG8_STAGE_B(PG8_SB(1, 1), cB + hB + kstep);
    PG8_WAIT_V(6); PG8_BAR;
    for (;;) {
        const bool has_next = p.next(ui + 1, nxt);
        const char* nA = has_next ? p.a_base(nxt) : cA; const char* nB = has_next ? p.b_base(nxt) : cB;
        if (P::GATHER) { if (has_next) { PG8_OFFS(nxt, nO); } else {
#pragma unroll
            for (int h = 0; h < 2; ++h)
#pragma unroll
                for (int i = 0; i < 2; ++i) nO[h][i] = cO[h][i]; } }
#pragma nounroll
        for (int t = 0; t < nt; t += 2) {
            if constexpr (P::HOOK) { if (p.is_hook(t)) p.hook(acc, cur, t, wr, wc, fr, fq); }
            const bool last = (t == nt - 2);
            if constexpr (P::PRE) { if (last) p.pre(cur, wr, fr); }
            const char* a1 = cA + (size_t)(t + 1) * kstep;
            const char* a2 = last ? nA : cA + (size_t)(t + 2) * kstep; const char* b2 = last ? nB : cB + (size_t)(t + 2) * kstep;
            const char* a3 = a2 + kstep; const char* b3 = b2 + kstep;
            PG8_LDB(B0, 0, 0); PG8_LDB(B1, 0, 1); PG8_SCHED; PG8_LDA(At, 0, 0); PG8_STAGE_A(PG8_SA(1, 1), a1 + hA, cO[1]);
            PG8_WAIT_V(8); PG8_WAIT_L(0); PG8_BAR; PG8_MMA(0, 0, At, B0); PG8_MMA(0, 1, At, B1); PG8_BAR; PG8_SCHED;
            if (P::GATHER && last) {
#pragma unroll
                for (int h = 0; h < 2; ++h)
#pragma unroll
                    for (int i = 0; i < 2; ++i) cO[h][i] = nO[h][i]; }
            PG8_LDA(At, 0, 1); PG8_STAGE_B(PG8_SB(0, 0), b2); PG8_STAGE_B(PG8_SB(0, 1), b2 + hB); PG8_STAGE_A(PG8_SA(0, 0), a2, cO[0]);
            PG8_WAIT_V(8); PG8_WAIT_L(0); PG8_BAR; PG8_MMA(1, 0, At, B0); PG8_MMA(1, 1, At, B1); PG8_BAR; PG8_SCHED;
            PG8_LDB(B0, 1, 0); PG8_LDB(B1, 1, 1); PG8_SCHED; PG8_LDA(At, 1, 0); PG8_STAGE_A(PG8_SA(0, 1), a2 + hA, cO[1]);
            PG8_WAIT_V(8); PG8_WAIT_L(0); PG8_BAR; PG8_MMA(0, 0, At, B0); PG8_MMA(0, 1, At, B1); PG8_BAR; PG8_SCHED;
            PG8_LDA(At, 1, 1); PG8_STAGE_B(PG8_SB(1, 0), b3); PG8_STAGE_B(PG8_SB(1, 1), b3 + hB); PG8_STAGE_A(PG8_SA(1, 0), a3, cO[0]);
            PG8_WAIT_V(8); PG8_WAIT_L(0); PG8_BAR; PG8_MMA(1, 0, At, B0); PG8_MMA(1, 1, At, B1); PG8_BAR; PG8_SCHED;
        }
        if constexpr (ALIGN_EPI) { if (wr == 0) PG8_BAR; }
        if constexpr (P::FP8) asm volatile("s_nop 15\n\ts_nop 7" ::: "memory");
        p.epi(acc, cur, wr, wc, fr, fq);
        if (!has_next) break;
#pragma unroll
        for (int a = 0; a < 2; ++a)
#pragma unroll
            for (int b = 0; b < 2; ++b)
#pragma unroll
                for (int m = 0; m < 4; ++m)
#pragma unroll
                    for (int n = 0; n < 2; ++n) acc[a][b][m][n] = (f32x4){0.f, 0.f, 0.f, 0.f};
        cur = nxt; cA = nA; cB = nB; ++ui;
        if constexpr (ALIGN_EPI) { if (wr == 1) PG8_BAR; }
    }
    PG8_WAIT_V(0);
    if constexpr (!ALIGN_EPI) { if (wr == 0) PG8_BAR; }
    PG8_BAR;
#undef PG8_SA
#undef PG8_SB
#undef PG8_STAGE_A
#undef PG8_STAGE_B
#undef PG8_LDA
#undef PG8_LDB
#undef PG8_LD8
#undef PG8_LO
#undef PG8_HI
#undef PG8_MMA
#undef PG8_WAIT_V
#undef PG8_WAIT_VF
#undef PG8_WAIT_L
#undef PG8_BAR
#undef PG8_SCHED
#undef PG8_OFFS
}
}
namespace pol {
using pg8::Unit; using pg8::Acc; using pg8::Order;
#define EPI_ROWS(u) const int row0 = (u).pm * 256 + wr * 64 + fr; const int cl = wc * 32 + 8 * fq;
#define FOR_AI_M _Pragma("unroll") for (int ai = 0; ai < 2; ++ai) _Pragma("unroll") for (int m = 0; m < 4; ++m)

template <bool OUT8> struct PolPlainT : Order {
    static constexpr bool HOOK = false, GATHER = false, FP8 = false, PRE = false; static constexpr int EPI_VM = 16;
    const char* A; const char* Bt; char* C; int lda_, ldb_, ldc_, nt_;
    int mper, n0, n1; size_t a0, a1, a2, b0, b1, b2, c0, c1, c2;
    __device__ __forceinline__ int nt() const { return nt_; }
    __device__ __forceinline__ int lda() const { return lda_; }
    __device__ __forceinline__ int ldb() const { return ldb_; }
    __device__ __forceinline__ void dec(const Unit& u, int& j0, int& j1, int& j2, int& r) const { const int j = u.pm / mper; r = u.pm % mper; j0 = j % n0; j1 = (j / n0) % n1; j2 = j / (n0 * n1); }
    __device__ __forceinline__ const char* a_base(const Unit& u) const { int j0, j1, j2, r; dec(u, j0, j1, j2, r); return A + j0 * a0 + j1 * a1 + j2 * a2 + (size_t)r * 256 * lda_; }
    __device__ __forceinline__ const char* b_base(const Unit& u) const { int j0, j1, j2, r; dec(u, j0, j1, j2, r); return Bt + j0 * b0 + j1 * b1 + j2 * b2 + (size_t)u.pn * 256 * ldb_; }
    __device__ __forceinline__ unsigned a_row(const Unit&, int) const { return 0u; }
    __device__ __forceinline__ bool is_hook(int) const { return false; }
    __device__ __forceinline__ void hook(Acc&, const Unit&, int, int, int, int, int) const {}
    __device__ __forceinline__ void epi(const Acc& acc, const Unit& u, int wr, int wc, int fr, int fq) const {
        int j0, j1, j2, r; dec(u, j0, j1, j2, r); const int cl = wc * 32 + 8 * fq; constexpr int EB = OUT8 ? 1 : 2;
        char* cb = C + j0 * c0 + j1 * c1 + j2 * c2 + (size_t)(r * 256 + wr * 64 + fr) * ldc_ + (size_t)(u.pn * 256 + cl) * EB;
        FOR_AI_M { char* rp = cb + (size_t)(ai * 128 + m * 16) * ldc_;
#pragma unroll
            for (int bj = 0; bj < 2; ++bj) { if constexpr (OUT8) *(u32x2*)(rp + bj * 128) = pack8_fp8(acc[ai][bj][m][0] * W8_SCALE, acc[ai][bj][m][1] * W8_SCALE); else *(u32x4*)(rp + bj * 256) = pack8(acc[ai][bj][m][0], acc[ai][bj][m][1]); } }
    }
};
typedef PolPlainT<false> PolPlain;
typedef PolPlainT<true> PolPlain8;

template <bool F8> struct PolZT : Order {
    static constexpr bool HOOK = false, GATHER = false, FP8 = F8, PRE = false; static constexpr int EPI_VM = 8;
    const char* A; const char* Bt; const u64* ss; LAS bf16* bzl; unsigned char* R1; LAS float* rsl; mutable int cpm;
    __device__ __forceinline__ int nt() const { return F8 ? D / 128 : D / 64; }
    __device__ __forceinline__ int lda() const { return F8 ? D : 2 * D; }
    __device__ __forceinline__ int ldb() const { return F8 ? D : 2 * D; }
    __device__ __forceinline__ const char* a_base(const Unit& u) const { return A + (size_t)u.pm * 256 * lda(); }
    __device__ __forceinline__ const char* b_base(const Unit& u) const { return Bt + (size_t)u.pn * 256 * ldb(); }
    __device__ __forceinline__ unsigned a_row(const Unit&, int) const { return 0u; }
    mutable float pr[2][4];
    __device__ __forceinline__ void pre(const Unit& u, int wr, int fr) const { const int row0 = u.pm * 256 + wr * 64 + fr; FOR_AI_M pr[ai][m] = (float)ss[row0 + ai * 128 + m * 16]; }
    __device__ __forceinline__ bool is_hook(int) const { return false; }
    __device__ __forceinline__ void hook(Acc&, const Unit&, int, int, int, int, int) const {}
    __device__ __forceinline__ void epi(const Acc& acc, const Unit& u, int wr, int wc, int fr, int fq) const {
        EPI_ROWS(u); const int pn = u.pn;
        unsigned char* r1 = R1; asm volatile("" : "+s"(r1));
        f32x4 bv[2][2];
#pragma unroll
        for (int bj = 0; bj < 2; ++bj) { const u32x4 bw = *(const LAS u32x4*)(bzl + pn * 256 + bj * 128 + cl); unpack8(bw, bv[bj][0], bv[bj][1]); }
        if (u.pm != cpm) {
            const int tl = (wr * 4 + wc) * 64 + fq * 16 + fr; if (tl < 256) rsl[tl] = row_rstd(ss, u.pm * 256 + tl);
            asm volatile("s_waitcnt lgkmcnt(0)" ::: "memory"); __builtin_amdgcn_s_barrier(); asm volatile("" ::: "memory"); cpm = u.pm; }
        float rs8[2][4];
        FOR_AI_M rs8[ai][m] = rsl[ai * 128 + wr * 64 + m * 16 + fr] * (F8 ? W8_INV : 1.f);
#define Z_(bj, n) (acc[ai][bj][m][n] * rs8[ai][m] + bv[bj][n])
        constexpr int NV = (!F8 || MK_Z_ALL_FP8) ? 10 : 0;
        bf16 *AG = (bf16*)(r1 + R_AG), *GB = (bf16*)(r1 + R_GB), *CP = (bf16*)(r1 + R_CP);
        if (pn < NV) {
            if (pn < 4) {
                FOR_AI_M { const int row = row0 + ai * 128 + m * 16; f32x4 o[2];
#pragma unroll
                    for (int n = 0; n < 2; ++n) { const f32x4 zv = Z_(0, n), zg = Z_(1, n);
#pragma unroll
                        for (int j = 0; j < 4; ++j) o[n][j] = zv[j] * sigmoidf_(zg[j]); }
                    *(u32x4*)((char*)AG + ((unsigned)row * CA + pn * 128 + cl) * 2u) = pack8(o[0], o[1]); }
            } else if (pn < 6) {
                FOR_AI_M { const int row = row0 + ai * 128 + m * 16;
#pragma unroll
                    for (int bj = 0; bj < 2; ++bj) *(u32x4*)((char*)GB + ((unsigned)row * CS + (pn - 4) * 256 + bj * 128 + cl) * 2u) = pack8(Z_(bj, 0), Z_(bj, 1)); }
            } else {
                FOR_AI_M { const int row = row0 + ai * 128 + m * 16;
                    *(u32x4*)((char*)CP + ((unsigned)row * CS + (pn - 6) * 128 + cl) * 2u) = pack8(Z_(0, 0) * Z_(1, 0), Z_(0, 1) * Z_(1, 1)); }
            }
        } else if constexpr (F8) {
            const int pq = pn - NV;
            bf16 *Q = (bf16*)(r1 + R_Q), *K = (bf16*)(r1 + R_K), *V = (bf16*)(r1 + R_V); unsigned char* Gt = r1 + R_G;
            if (pq < 9) {
                const int which = pq / 3, g = pq % 3; bf16* base = which == 0 ? Q : (which == 1 ? K : V); const float sc = which == 0 ? C2 : 1.f;
                FOR_AI_M { const int row = row0 + ai * 128 + m * 16;
#pragma unroll
                    for (int bj = 0; bj < 2; ++bj) *(u32x4*)((char*)base + ((unsigned)row * DW + g * 256 + bj * 128 + cl) * 2u) = pack8(Z_(bj, 0) * sc, Z_(bj, 1) * sc); }
            } else {
                FOR_AI_M {
#pragma unroll
                    for (int bj = 0; bj < 2; ++bj) { f32x4 o[2];
#pragma unroll
                        for (int n = 0; n < 2; ++n) { const f32x4 zz = Z_(bj, n);
#pragma unroll
                            for (int j = 0; j < 4; ++j) o[n][j] = sigmoidf_(zz[j]); }
                        *(u32x2*)(Gt + gate_off(u.pm, (pq - 9) >> 2, (pq - 9) & 3, wr * 4 + wc, ai, m, bj, fq * 16 + fr)) = pack8_gate(o[0], o[1]); } }
            }
        }
#undef Z_
    }
};
typedef PolZT<false> PolZB;
typedef PolZT<true> PolZ8;

struct PolMerge : Order {
    static constexpr bool HOOK = true, GATHER = false, FP8 = false, PRE = false; static constexpr int EPI_VM = 16;
    const char* A; const char* Bt; const unsigned char* Gt; bf16* MRG;
    __device__ __forceinline__ int nt() const { return KCAT / 64; }
    __device__ __forceinline__ int lda() const { return KCAT * 2; }
    __device__ __forceinline__ int ldb() const { return KCAT * 2; }
    __device__ __forceinline__ const char* a_base(const Unit& u) const { return A + (size_t)u.pm * 256 * KCAT * 2; }
    __device__ __forceinline__ const char* b_base(const Unit& u) const { return Bt + (size_t)u.pn * 256 * KCAT * 2; }
    __device__ __forceinline__ unsigned a_row(const Unit&, int) const { return 0u; }
    __device__ __forceinline__ bool is_hook(int t) const { return t == 8 || t == 12; }
    __device__ __forceinline__ void hook(Acc& acc, const Unit& u, int t, int wr, int wc, int fr, int fq) const {
        const int br = (t == 8) ? 0 : 1;
        int lq = fq * 16 + fr; asm volatile("" : "+v"(lq));
        u32x2 wa[2][4][2], wb[2][4][2];
        FOR_AI_M {
#pragma unroll
            for (int bj = 0; bj < 2; ++bj) { wa[ai][m][bj] = *(const u32x2*)(Gt + gate_off(u.pm, br, u.pn, wr * 4 + wc, ai, m, bj, lq)); wb[ai][m][bj] = *(const u32x2*)(Gt + gate_off(u.pm, br + 1, u.pn, wr * 4 + wc, ai, m, bj, lq)); } }
        FOR_AI_M {
#pragma unroll
            for (int bj = 0; bj < 2; ++bj) { f32x4 a0, a1, b0, b1; unpack8_gate(wa[ai][m][bj], a0, a1); unpack8_gate(wb[ai][m][bj], b0, b1);
#pragma unroll
                for (int j = 0; j < 4; ++j) { acc[ai][bj][m][0][j] *= a0[j] * frcp(b0[j]); acc[ai][bj][m][1][j] *= a1[j] * frcp(b1[j]); } } }
    }
    __device__ __forceinline__ void epi(const Acc& acc, const Unit& u, int wr, int wc, int fr, int fq) const {
        EPI_ROWS(u);
        u32x2 gw[2][4][2];
        FOR_AI_M { gw[ai][m][0] = *(const u32x2*)(Gt + gate_off(u.pm, 2, u.pn, wr * 4 + wc, ai, m, 0, fq * 16 + fr)); gw[ai][m][1] = *(const u32x2*)(Gt + gate_off(u.pm, 2, u.pn, wr * 4 + wc, ai, m, 1, fq * 16 + fr)); }
        FOR_AI_M { const int row = row0 + ai * 128 + m * 16;
#pragma unroll
            for (int bj = 0; bj < 2; ++bj) { f32x4 a0, a1; unpack8_gate(gw[ai][m][bj], a0, a1);
                *(u32x4*)((char*)MRG + ((unsigned)row * (unsigned)D + u.pn * 256 + bj * 128 + cl) * 2u) = pack8(acc[ai][bj][m][0] * a0 * (1.f / 255.f), acc[ai][bj][m][1] * a1 * (1.f / 255.f)); } }
    }
};

template <bool F8> struct PolResT : Order {
    static constexpr bool HOOK = false, GATHER = false, FP8 = F8, PRE = false; static constexpr int EPI_VM = 16;
    const char* A; const char* Bt; size_t b_batch; int K; bf16* XB; u64* ssn; unsigned char* X8; float ascale;
    __device__ __forceinline__ int nt() const { return F8 ? K / 128 : K / 64; }
    __device__ __forceinline__ int lda() const { return F8 ? K : K * 2; }
    __device__ __forceinline__ int ldb() const { return F8 ? K : K * 2; }
    __device__ __forceinline__ const char* a_base(const Unit& u) const { return A + (size_t)u.pm * 256 * lda(); }
    __device__ __forceinline__ const char* b_base(const Unit& u) const { return Bt + (u.pm >= 64 ? b_batch : (size_t)0) + (size_t)u.pn * 256 * ldb(); }
    __device__ __forceinline__ unsigned a_row(const Unit&, int) const { return 0u; }
    __device__ __forceinline__ bool is_hook(int) const { return false; }
    __device__ __forceinline__ void hook(Acc&, const Unit&, int, int, int, int, int) const {}
    __device__ __forceinline__ void epi(const Acc& acc, const Unit& u, int wr, int wc, int fr, int fq) const {
        EPI_ROWS(u); const float as = ascale;
        const char* xbc = (const char*)XB; char* xbw = (char*)XB;
        u32x4 old[2][4][2];
        FOR_AI_M { const unsigned ob = ((unsigned)(row0 + ai * 128 + m * 16) * (unsigned)D + (unsigned)(u.pn * 256 + cl)) * 2u; old[ai][m][0] = *(const u32x4*)(xbc + ob); old[ai][m][1] = *(const u32x4*)(xbc + ob + 256u); }
        FOR_AI_M { const unsigned row = (unsigned)(row0 + ai * 128 + m * 16); const unsigned oe = row * (unsigned)D + (unsigned)(u.pn * 256 + cl); float sq = 0.f;
#pragma unroll
            for (int bj = 0; bj < 2; ++bj) { f32x4 v0, v1;
                unpack8(old[ai][m][bj], v0, v1);
                v0 = v0 + acc[ai][bj][m][0] * as; v1 = v1 + acc[ai][bj][m][1] * as;
                sq += (v0[0] * v0[0] + v0[1] * v0[1]) + (v0[2] * v0[2] + v0[3] * v0[3]) + (v1[0] * v1[0] + v1[1] * v1[1]) + (v1[2] * v1[2] + v1[3] * v1[3]);
                *(u32x4*)(xbw + (oe + bj * 128u) * 2u) = pack8(v0, v1);
                if (X8) *(u32x2*)(X8 + (oe + bj * 128u)) = pack8_fp8(v0, v1); }
            sq += __shfl_xor(sq, 16); sq += __shfl_xor(sq, 32);
            if (fq == 0) row_ss_add(ssn, (int)row, sq); }
    }
};
typedef PolResT<false> PolRes;
typedef PolResT<true> PolRes8;

struct PolXS : Order {
    static constexpr bool HOOK = false, GATHER = false, FP8 = true, PRE = false; static constexpr int EPI_VM = 16;
    const char* A; const char* Bt; size_t b_batch; const u64* ss; unsigned char* P; LAS float* xch;
    mutable int parity;
    __device__ __forceinline__ int nt() const { return D / 128; }
    __device__ __forceinline__ int lda() const { return D; }
    __device__ __forceinline__ int ldb() const { return D; }
    __device__ __forceinline__ const char* a_base(const Unit& u) const { return A + (size_t)u.pm * 256 * D; }
    __device__ __forceinline__ const char* b_base(const Unit& u) const { return Bt + (u.pm >= 64 ? b_batch : (size_t)0) + (size_t)u.pn * 256 * D; }
    __device__ __forceinline__ unsigned a_row(const Unit&, int) const { return 0u; }
    mutable float pr[2][4];
    __device__ __forceinline__ void pre(const Unit& u, int wr, int fr) const { const int row0 = u.pm * 256 + wr * 64 + fr; FOR_AI_M pr[ai][m] = (float)ss[row0 + ai * 128 + m * 16]; }
    __device__ __forceinline__ bool is_hook(int) const { return false; }
    __device__ __forceinline__ void hook(Acc&, const Unit&, int, int, int, int, int) const {}
    __device__ __forceinline__ void epi(const Acc& acc, const Unit& u, int wr, int wc, int fr, int fq) const {
        EPI_ROWS(u);
        LAS float* xb = xch + parity * 2048; parity ^= 1;
        Acc& pa = const_cast<Acc&>(acc);
        float rs8[2][4], mloc[2][4];
        FOR_AI_M rs8[ai][m] = row_rstd(ss, row0 + ai * 128 + m * 16) * W8_INV;
        FOR_AI_M { const float rs = rs8[ai][m];
            float mx = -3.0e38f;
#pragma unroll
            for (int bj = 0; bj < 2; ++bj)
#pragma unroll
                for (int n = 0; n < 2; ++n)
#pragma unroll
                    for (int j = 0; j < 4; ++j) mx = fmaxf(mx, acc[ai][bj][m][n][j] * rs);
            mx = fmaxf(mx, __shfl_xor(mx, 16)); mx = fmaxf(mx, __shfl_xor(mx, 32));
            float sm = 0.f;
#pragma unroll
            for (int bj = 0; bj < 2; ++bj)
#pragma unroll
                for (int n = 0; n < 2; ++n)
#pragma unroll
                    for (int j = 0; j < 4; ++j) { const float pv = fexp2(acc[ai][bj][m][n][j] * rs - mx); pa[ai][bj][m][n][j] = pv; sm += pv; }
            sm += __shfl_xor(sm, 16); sm += __shfl_xor(sm, 32); mloc[ai][m] = mx;
            if (fq == 0) { const int rl = ai * 128 + wr * 64 + m * 16 + fr; *(LAS f32x2*)(xb + (rl * 4 + wc) * 2) = (f32x2){mx, sm}; } }
        asm volatile("s_waitcnt lgkmcnt(0)" ::: "memory"); __builtin_amdgcn_s_barrier(); asm volatile("" ::: "memory");
        FOR_AI_M { const int row = row0 + ai * 128 + m * 16;
            const int rl = ai * 128 + wr * 64 + m * 16 + fr;
            const f32x4 e0 = *(const LAS f32x4*)(xb + rl * 8), e1 = *(const LAS f32x4*)(xb + rl * 8 + 4);
            const float MX = fmaxf(fmaxf(e0[0], e0[2]), fmaxf(e1[0], e1[2]));
            const float L = e0[1] * fexp2(e0[0] - MX) + e0[3] * fexp2(e0[2] - MX) + e1[1] * fexp2(e1[0] - MX) + e1[3] * fexp2(e1[2] - MX);
            const float inv = frcp(L) * W8_SCALE * fexp2(mloc[ai][m] - MX);
#pragma unroll
            for (int bj = 0; bj < 2; ++bj) { f32x4 o[2];
#pragma unroll
                for (int n = 0; n < 2; ++n)
#pragma unroll
                    for (int j = 0; j < 4; ++j) o[n][j] = pa[ai][bj][m][n][j] * inv;
                *(u32x2*)(P + ((unsigned)row * (unsigned)D + u.pn * 256 + bj * 128 + cl)) = pack8_fp8(o[0], o[1]); } }
    }
};

struct PolUp : Order {
    static constexpr bool HOOK = false, GATHER = false, FP8 = true, PRE = false; static constexpr int EPI_VM = 8;
    const char* A; const char* Bt; const u64* ss; unsigned char* U; int out16; LAS float* rsl; mutable int cpm;
    __device__ __forceinline__ int nt() const { return D / 128; }
    __device__ __forceinline__ int lda() const { return D; }
    __device__ __forceinline__ int ldb() const { return D; }
    __device__ __forceinline__ const char* a_base(const Unit& u) const { return A + (size_t)u.pm * 256 * D; }
    __device__ __forceinline__ const char* b_base(const Unit& u) const { return Bt + (size_t)u.pn * 256 * D; }
    __device__ __forceinline__ unsigned a_row(const Unit&, int) const { return 0u; }
    mutable float pr[2][4];
    __device__ __forceinline__ void pre(const Unit& u, int wr, int fr) const { const int row0 = u.pm * 256 + wr * 64 + fr; FOR_AI_M pr[ai][m] = (float)ss[row0 + ai * 128 + m * 16]; }
    __device__ __forceinline__ bool is_hook(int) const { return false; }
    __device__ __forceinline__ void hook(Acc&, const Unit&, int, int, int, int, int) const {}
    __device__ __forceinline__ void epi(const Acc& acc, const Unit& u, int wr, int wc, int fr, int fq) const {
        EPI_ROWS(u);
        if (u.pm != cpm) { const int tl = (wr * 4 + wc) * 64 + fq * 16 + fr; if (tl < 256) rsl[tl] = row_rstd(ss, u.pm * 256 + tl);
            asm volatile("s_waitcnt lgkmcnt(0)" ::: "memory"); __builtin_amdgcn_s_barrier(); asm volatile("" ::: "memory"); cpm = u.pm; }
        float rs8[2][4];
        FOR_AI_M rs8[ai][m] = rsl[ai * 128 + wr * 64 + m * 16 + fr] * W8_INV;
        FOR_AI_M { const int row = row0 + ai * 128 + m * 16; const float rs = rs8[ai][m]; const float cs = -LOG2E * rs, s2 = rs * rs;
            f32x4 o[2];
#pragma unroll
            for (int n = 0; n < 2; ++n)
#pragma unroll
                for (int j = 0; j < 4; ++j) { const float a = acc[ai][0][m][n][j], b = acc[ai][1][m][n][j]; o[n][j] = (a * b) * frcp(1.f + fexp2(cs * a)) * s2; }
            if (out16) *(u32x4*)(U + ((unsigned)row * (unsigned)DFF + u.pn * 128 + cl) * 2u) = pack8(o[0], o[1]); else *(u32x2*)(U + ((unsigned)row * (unsigned)DFF + u.pn * 128 + cl)) = pack8_fp8(o[0], o[1]); }
    }
};

struct PolUpB : Order {
    static constexpr bool HOOK = false, GATHER = false, FP8 = false, PRE = false; static constexpr int EPI_VM = 8;
    const char* A; const char* Bt; const u64* ss; unsigned char* U; int out16; LAS float* rsl; mutable int cpm;
    __device__ __forceinline__ int nt() const { return 16; }
    __device__ __forceinline__ int lda() const { return 2048; }
    __device__ __forceinline__ int ldb() const { return 2048; }
    __device__ __forceinline__ const char* a_base(const Unit& u) const { return A + (size_t)u.pm * 256 * 2048; }
    __device__ __forceinline__ const char* b_base(const Unit& u) const { return Bt + (size_t)u.pn * 256 * 2048; }
    __device__ __forceinline__ unsigned a_row(const Unit&, int) const { return 0u; }
    mutable float pr[2][4];
    __device__ __forceinline__ void pre(const Unit& u, int wr, int fr) const { const int row0 = u.pm * 256 + wr * 64 + fr; FOR_AI_M pr[ai][m] = (float)ss[row0 + ai * 128 + m * 16]; }
    __device__ __forceinline__ bool is_hook(int) const { return false; }
    __device__ __forceinline__ void hook(Acc&, const Unit&, int, int, int, int, int) const {}
    __device__ __forceinline__ void epi(const Acc& acc, const Unit& u, int wr, int wc, int fr, int fq) const {
        EPI_ROWS(u);
        if (u.pm != cpm) { const int tl = (wr * 4 + wc) * 64 + fq * 16 + fr; if (tl < 256) rsl[tl] = row_rstd(ss, u.pm * 256 + tl);
            asm volatile("s_waitcnt lgkmcnt(0)" ::: "memory"); __builtin_amdgcn_s_barrier(); asm volatile("" ::: "memory"); cpm = u.pm; }
        float rs8[2][4];
        FOR_AI_M rs8[ai][m] = rsl[ai * 128 + wr * 64 + m * 16 + fr];
        FOR_AI_M { const int row = row0 + ai * 128 + m * 16; const float rs = rs8[ai][m]; const float cs = -LOG2E * rs, s2 = rs * rs;
            f32x4 o[2];
#pragma unroll
            for (int n = 0; n < 2; ++n)
#pragma unroll
                for (int j = 0; j < 4; ++j) { const float a = acc[ai][0][m][n][j], b = acc[ai][1][m][n][j]; o[n][j] = (a * b) * frcp(1.f + fexp2(cs * a)) * s2; }
            if (out16) *(u32x4*)(U + ((unsigned)row * (unsigned)DFF + u.pn * 128 + cl) * 2u) = pack8(o[0], o[1]); else *(u32x2*)(U + ((unsigned)row * (unsigned)DFF + u.pn * 128 + cl)) = pack8_fp8(o[0], o[1]); }
    }
};

struct MoeTiles {
    int tb[2][9];
    __device__ __forceinline__ void init(const unsigned* cnt  ) {
#pragma unroll
        for (int p = 0; p < 2; ++p) { int s = 0;
#pragma unroll
            for (int e = 0; e < 8; ++e) { tb[p][e] = s; s += ((int)cnt[64 * (8 * p + e)] + 255) >> 8; }
            tb[p][8] = s; }
    }
    __device__ __forceinline__ int ntiles() const { return tb[0][8] + tb[1][8]; }
    __device__ __forceinline__ void decode(int pm, int& e, int& st) const {
        const int p = pm >= tb[0][8] ? 1 : 0, rt = pm - (p ? tb[0][8] : 0); e = 0;
#pragma unroll
        for (int k = 1; k < 8; ++k) e += (rt >= (p ? tb[1][k] : tb[0][k])) ? 1 : 0;
        st = p * MAXRT + rt; }
};

struct PolMoeUp : Order {
    static constexpr bool HOOK = false, GATHER = true, FP8 = true, PRE = false; static constexpr int EPI_VM = 8;
    const char* A; const char* Bt; const int* list; const float* lr; unsigned char* U; MoeTiles mt; mutable float pr[2][4];
    __device__ __forceinline__ int nt() const { return D / 128; }
    __device__ __forceinline__ int lda() const { return D; }
    __device__ __forceinline__ int ldb() const { return D; }
    __device__ __forceinline__ const char* a_base(const Unit&) const { return A; }
    __device__ __forceinline__ const char* b_base(const Unit& u) const { int e, st; mt.decode(u.pm, e, st); return Bt + (size_t)e * (2 * MFF) * D + (size_t)u.pn * 256 * D; }
    __device__ __forceinline__ unsigned a_row(const Unit& u, int r) const { int e, st; mt.decode(u.pm, e, st); int tok = list[st * 256 + r]; tok = tok < 0 ? 0 : tok; return (unsigned)tok * (unsigned)D; }
    __device__ __forceinline__ void pre(const Unit& u, int wr, int fr) const { int e, st; mt.decode(u.pm, e, st); const int row0 = st * 256 + wr * 64 + fr; FOR_AI_M pr[ai][m] = lr[row0 + ai * 128 + m * 16]; }
    __device__ __forceinline__ bool is_hook(int) const { return false; }
    __device__ __forceinline__ void hook(Acc&, const Unit&, int, int, int, int, int) const {}
    __device__ __forceinline__ void epi(const Acc& acc, const Unit& u, int wr, int wc, int fr, int fq) const {
        int e, st; mt.decode(u.pm, e, st); const int row0 = st * 256 + wr * 64 + fr; const int cl = wc * 32 + 8 * fq;
        FOR_AI_M { const int row = row0 + ai * 128 + m * 16; const float cs = -LOG2E * W8_INV, s2 = W8_INV * W8_INV;
            f32x4 o[2];
#pragma unroll
            for (int n = 0; n < 2; ++n)
#pragma unroll
                for (int j = 0; j < 4; ++j) { const float a = acc[ai][0][m][n][j], b = acc[ai][1][m][n][j]; o[n][j] = (a * b) * frcp(1.f + fexp2(cs * a)) * s2; }
            *(u32x2*)(U + ((unsigned)row * (unsigned)MFF + u.pn * 128 + cl)) = pack8_fp8(o[0], o[1]); }
    }
};
struct PolMoeDown : Order {
    static constexpr bool HOOK = false, GATHER = false, FP8 = true, PRE = false; static constexpr int EPI_VM = 16;
    const char* A; const char* Bt; const float* lw; bf16* Y; MoeTiles mt; mutable float pr[2][4]; int l_off, l_end;
    __device__ __forceinline__ bool next(int i, Unit& u) const { const long L = (long)l_off + (long)i * G + c; if (L >= l_end) return false; u.pm = (int)(L >> 2); u.pn = (int)(L & 3); return true; }
    __device__ __forceinline__ int nt() const { return MFF / 128; }
    __device__ __forceinline__ int lda() const { return MFF; }
    __device__ __forceinline__ int ldb() const { return MFF; }
    __device__ __forceinline__ const char* a_base(const Unit& u) const { int e, st; mt.decode(u.pm, e, st); return A + (size_t)st * 256 * MFF; }
    __device__ __forceinline__ const char* b_base(const Unit& u) const { int e, st; mt.decode(u.pm, e, st); return Bt + (size_t)e * D * MFF + (size_t)u.pn * 256 * MFF; }
    __device__ __forceinline__ unsigned a_row(const Unit&, int) const { return 0u; }
    __device__ __forceinline__ void pre(const Unit& u, int wr, int fr) const { int e, st; mt.decode(u.pm, e, st); const int row0 = st * 256 + wr * 64 + fr; FOR_AI_M pr[ai][m] = lw[row0 + ai * 128 + m * 16]; }
    __device__ __forceinline__ bool is_hook(int) const { return false; }
    __device__ __forceinline__ void hook(Acc&, const Unit&, int, int, int, int, int) const {}
    __device__ __forceinline__ void epi(const Acc& acc, const Unit& u, int wr, int wc, int fr, int fq) const {
        int e, st; mt.decode(u.pm, e, st); const int row0 = st * 256 + wr * 64 + fr; const int cl = wc * 32 + 8 * fq;
        FOR_AI_M { const int row = row0 + ai * 128 + m * 16; const float w = W8_INV;
#pragma unroll
            for (int bj = 0; bj < 2; ++bj) *(u32x4*)((char*)Y + ((unsigned)row * (unsigned)D + u.pn * 256 + bj * 128 + cl) * 2u) = pack8(acc[ai][bj][m][0] * w, acc[ai][bj][m][1] * w); }
    }
};
}
struct Ctx {
    LAS unsigned char* lds; int tid, lane, wave, G, bid, gw, NGW;
};

__device__ __forceinline__ int zmapB(int n) {
    const int pn = n >> 8, c = n & 255, bj = c >> 7, cc = c & 127;
    if (pn < 4) return OFF_A + (bj ? 512 : 0) + pn * 128 + cc;
    if (pn < 6) return OFF_CB + (pn - 4) * 256 + c;
    return (bj ? OFF_CH : OFF_CC) + (pn - 6) * 128 + cc;
}
__device__ __forceinline__ int zmap8(int n) {
    if (MK_Z_ALL_FP8) { if (n < 10 * 256) return zmapB(n); n -= 10 * 256; }
    const int pn = n >> 8, c = n & 255;
    if (pn < 9) return OFF_Q + pn * 256 + c;
    return OFF_G + (pn - 9) * 256 + c;
}
constexpr int TR_SCR = 64 * 65 * 4;
template <int MAP, bool OUT8 = false>
__device__ __forceinline__ void tr_matrix(const Ctx& F, int& rot, const float* src, const float* src2, int K, int N, int ldsrc, bf16* dst, int lddst, int dstk0, const float* gain) {
    LAS float* scr = (LAS float*)(F.lds + F.wave * TR_SCR);
    const int nblk = N / 64, nitems = (K / 64) * nblk, lane = F.lane;
    const int first = (F.gw - rot + F.NGW) % F.NGW; rot = (rot + nitems) % F.NGW;
    f32x4 v[16];
#define TR_LOAD(it_) do { const int kb_ = (it_) / nblk, nb_ = (it_) % nblk, n0_ = 64 * nb_; const float* s_ = src; int sn0_ = n0_; \
        if (MAP == 1) sn0_ = zmapB(n0_); if (MAP == 3) sn0_ = zmap8(n0_); \
        if (MAP == 2) { const int pn_ = n0_ >> 8, c_ = n0_ & 255; s_ = (c_ >> 7) ? src2 : src; sn0_ = pn_ * 128 + (c_ & 127); } \
        _Pragma("unroll") for (int i = 0; i < 16; ++i) v[i] = *(const f32x4*)(s_ + (size_t)(64 * kb_ + 4 * i + (lane >> 4)) * ldsrc + sn0_ + 4 * (lane & 15)); } while (0)
    if (first < nitems) TR_LOAD(first);
    for (int it = first; it < nitems; it += F.NGW) {
        const int kb = it / nblk, nb = it % nblk, k0 = 64 * kb, n0 = 64 * nb;
#pragma unroll
        for (int i = 0; i < 16; ++i) { const int kk = 4 * i + (lane >> 4); f32x4 w = v[i]; if (gain) w = w * gain[k0 + kk];
            LAS float* q = scr + kk * 65 + 4 * (lane & 15); q[0] = w[0]; q[1] = w[1]; q[2] = w[2]; q[3] = w[3]; }
        LDS_WAIT(); asm volatile("" ::: "memory");
        if (it + F.NGW < nitems) TR_LOAD(it + F.NGW);
        const int c = lane & 7;
#pragma unroll
        for (int j = 0; j < 8; ++j) { const int n = (lane >> 3) + 8 * j; const LAS float* q = scr + (8 * c) * 65 + n;
            if constexpr (OUT8) { u32x2 o; o.x = pk4_fp8(clamp8(q[0 * 65] * W8_SCALE), clamp8(q[1 * 65] * W8_SCALE), clamp8(q[2 * 65] * W8_SCALE), clamp8(q[3 * 65] * W8_SCALE));
                o.y = pk4_fp8(clamp8(q[4 * 65] * W8_SCALE), clamp8(q[5 * 65] * W8_SCALE), clamp8(q[6 * 65] * W8_SCALE), clamp8(q[7 * 65] * W8_SCALE));
                *(u32x2*)((unsigned char*)dst + (size_t)(n0 + n) * lddst + dstk0 + k0 + 8 * c) = o; }
            else { u32x4 o; o.x = cvt_pk_bf16(q[0 * 65], q[1 * 65]); o.y = cvt_pk_bf16(q[2 * 65], q[3 * 65]); o.z = cvt_pk_bf16(q[4 * 65], q[5 * 65]); o.w = cvt_pk_bf16(q[6 * 65], q[7 * 65]);
                *(u32x4*)(dst + (size_t)(n0 + n) * lddst + dstk0 + k0 + 8 * c) = o; } }
        LDS_WAIT(); asm volatile("" ::: "memory");
    }
#undef TR_LOAD
}
__device__ __forceinline__ void cv_rows(const Ctx& F, const float* src, bf16* dst, int R, const float* rowgain, float scale) {
    for (int r = F.gw; r < R; r += F.NGW) { const float g = rowgain[r] * scale; const f32x4* s = (const f32x4*)(src + (size_t)r * D) + F.lane; unsigned long long* o = (unsigned long long*)(dst + (size_t)r * D) + F.lane;
#pragma unroll
        for (int j = 0; j < 4; ++j) { const f32x4 v = s[64 * j] * g; o[64 * j] = (unsigned long long)pk2(v[0], v[1]) | ((unsigned long long)pk2(v[2], v[3]) << 32); } }
}
__device__ __forceinline__ void rows_raw_ss(const Ctx& F, const float* x, bf16* xb, unsigned char* x8, u64* ss) {
    f32x4 v[4], nv[4];
    if (F.gw < M) { const f32x4* s = (const f32x4*)(x + (size_t)F.gw * D) + F.lane;
#pragma unroll
        for (int j = 0; j < 4; ++j) v[j] = s[64 * j]; }
    for (int r = F.gw; r < M; r += F.NGW) {
        if (r + F.NGW < M) { const f32x4* s = (const f32x4*)(x + (size_t)(r + F.NGW) * D) + F.lane;
#pragma unroll
            for (int j = 0; j < 4; ++j) nv[j] = s[64 * j]; }
        unsigned long long* o = (unsigned long long*)(xb + (size_t)r * D) + F.lane; unsigned* o8 = (unsigned*)(x8 + (size_t)r * D) + F.lane; float sq = 0.f;
#pragma unroll
        for (int j = 0; j < 4; ++j) { sq += (v[j][0] * v[j][0] + v[j][1] * v[j][1]) + (v[j][2] * v[j][2] + v[j][3] * v[j][3]);
            o[64 * j] = (unsigned long long)cvt_pk_bf16(v[j][0], v[j][1]) | ((unsigned long long)cvt_pk_bf16(v[j][2], v[j][3]) << 32); o8[64 * j] = pk4_fp8(clamp8(v[j][0]), clamp8(v[j][1]), clamp8(v[j][2]), clamp8(v[j][3])); }
        sq = wave_sum(sq); if (F.lane == 0) ss[r] = (u64)(sq * SS_SCALE);
#pragma unroll
        for (int j = 0; j < 4; ++j) v[j] = nv[j]; }
}
__device__ __forceinline__ void rows_rmsnorm_bf16(const Ctx& F, const float* x, const float* g, bf16* out, int R) {
    for (int r = F.gw; r < R; r += F.NGW) { const f32x4* s = (const f32x4*)(x + (size_t)r * D) + F.lane; const f32x4* gp = (const f32x4*)g + F.lane; unsigned long long* o = (unsigned long long*)(out + (size_t)r * D) + F.lane;
        f32x4 v[4]; float sq = 0.f;
#pragma unroll
        for (int j = 0; j < 4; ++j) { v[j] = s[64 * j]; sq += (v[j][0] * v[j][0] + v[j][1] * v[j][1]) + (v[j][2] * v[j][2] + v[j][3] * v[j][3]); }
        const float rs = __builtin_amdgcn_rsqf(wave_sum(sq) * (1.f / D) + EPS);
#pragma unroll
        for (int j = 0; j < 4; ++j) { const f32x4 w = v[j] * rs * gp[64 * j]; o[64 * j] = (unsigned long long)pk2(w[0], w[1]) | ((unsigned long long)pk2(w[2], w[3]) << 32); } }
}
__device__ __forceinline__ void rows_final(const Ctx& F, int gw, int NGW, const bf16* xb, const bf16* Y, const int* sl, const float* rw, const float* g, float* out, int nt0, int late_tile, int want_late) {
    u32x4 cx[2], c0[2], c1[2], nx[2], n0[2], n1[2]; f32x2 cw, nw; bool cok = false, nok = false;
#define RF_LOAD(r_, X_, A_, B_, W_, OK_) do { const int s0_ = sl[r_], s1_ = sl[M + (r_)]; const int t0_ = s0_ >> 8, t1_ = nt0 + ((s1_ - MOE_ROWS) >> 8); \
        OK_ = ((t0_ >= late_tile || t1_ >= late_tile) ? 1 : 0) == want_late; \
        if (OK_) { const u32x4* px_ = (const u32x4*)(xb + (size_t)(r_) * D) + F.lane; const u32x4* p0_ = (const u32x4*)(Y + (size_t)s0_ * D) + F.lane; \
        const u32x4* p1_ = (const u32x4*)(Y + (size_t)s1_ * D) + F.lane; X_[0] = px_[0]; X_[1] = px_[64]; A_[0] = p0_[0]; A_[1] = p0_[64]; B_[0] = p1_[0]; B_[1] = p1_[64]; W_ = *(const f32x2*)(rw + 2 * (r_)); } } while (0)
    f32x4 gv[4];
#pragma unroll
    for (int j = 0; j < 2; ++j) { gv[2 * j] = *(const f32x4*)(g + 512 * j + 8 * F.lane); gv[2 * j + 1] = *(const f32x4*)(g + 512 * j + 8 * F.lane + 4); }
    if (gw < M) RF_LOAD(gw, cx, c0, c1, cw, cok);
    for (int r = gw; r < M; r += NGW) {
        if (r + NGW < M) RF_LOAD(r + NGW, nx, n0, n1, nw, nok);
        if (cok) {
            f32x4 v[4]; float sq = 0.f;
#pragma unroll
            for (int j = 0; j < 2; ++j) { f32x4 a0, a1, b0, b1, e0, e1; unpack8(cx[j], a0, a1); unpack8(c0[j], b0, b1); unpack8(c1[j], e0, e1);
                v[2 * j] = a0 + b0 * cw.x + e0 * cw.y; v[2 * j + 1] = a1 + b1 * cw.x + e1 * cw.y;
                sq += (v[2 * j][0] * v[2 * j][0] + v[2 * j][1] * v[2 * j][1]) + (v[2 * j][2] * v[2 * j][2] + v[2 * j][3] * v[2 * j][3]) + (v[2 * j + 1][0] * v[2 * j + 1][0] + v[2 * j + 1][1] * v[2 * j + 1][1]) + (v[2 * j + 1][2] * v[2 * j + 1][2] + v[2 * j + 1][3] * v[2 * j + 1][3]); }
            const float rs = __builtin_amdgcn_rsqf(wave_sum(sq) * (1.f / D) + EPS);
#pragma unroll
            for (int j = 0; j < 2; ++j) { f32x4* o = (f32x4*)(out + (size_t)r * D + 512 * j + 8 * F.lane); o[0] = v[2 * j] * rs * gv[2 * j]; o[1] = v[2 * j + 1] * rs * gv[2 * j + 1]; } }
#pragma unroll
        for (int j = 0; j < 2; ++j) { cx[j] = nx[j]; c0[j] = n0[j]; c1[j] = n1[j]; }
        cw = nw; cok = nok; nok = false; }
#undef RF_LOAD
}

constexpr int DA_KP = 144, DA_VOFF = 256 * DA_KP, DA_IMG = 2 * DA_VOFF;
struct DaUnit { int b, g, h, d, r, n, col0; };
__device__ __forceinline__ DaUnit da_decode(int u) { DaUnit q; const int blk = u & 127; q.h = (u >> 7) & 3; q.g = (u >> 9) % 3; q.b = u / 1536;
    q.d = q.g == 0 ? 1 : (q.g == 1 ? 4 : 16); const int npr = 128 / q.d; q.r = blk / npr; q.n = blk % npr; q.col0 = q.g * 256 + q.h * 64; return q; }
__device__ __forceinline__ void da_load(const DaUnit& q, int tid, const bf16* Kg, const bf16* Vg, u32x4 (&kv)[4], u32x4 (&vv)[4]) {
#pragma unroll
    for (int i = 0; i < 4; ++i) { const int c = tid + 512 * i, j = c >> 3, part = c & 7; const int lk = 128 * (q.n - 1) + j;
        kv[i] = (u32x4){0u, 0u, 0u, 0u}; vv[i] = (u32x4){0u, 0u, 0u, 0u};
        if (lk >= 0) { const size_t off = ((size_t)q.b * SEQ + (size_t)lk * q.d + q.r) * DW + q.col0 + part * 8; kv[i] = *(const u32x4*)(Kg + off); vv[i] = *(const u32x4*)(Vg + off); } }
}
__device__ __forceinline__ void dil_attn_phase(const Ctx& F, bf16* QO, const bf16* Kg, const bf16* Vg, float* LSE) {
    const int tid = F.tid, lane = F.lane, fr = lane & 15, fq = lane >> 4;
    int w = tid >> 6; asm volatile("" : "+v"(w));
    const float NINF = -__builtin_inff();
    const int NU = NB * 3 * 4 * 128;
    int par = 0;
    u32x4 kv[4], vv[4]; bf16x8 qn[2];
#define DA_QLOAD(q_) do { const size_t rq_ = (size_t)(q_).b * SEQ + (size_t)(128 * (q_).n + 16 * w + fr) * (q_).d + (q_).r; \
        _Pragma("unroll") for (int ks = 0; ks < 2; ++ks) qn[ks] = *(const bf16x8*)(QO + rq_ * DW + (q_).col0 + 32 * ks + 8 * fq); } while (0)
    if (F.bid < NU) { const DaUnit q0 = da_decode(F.bid); da_load(q0, tid, Kg, Vg, kv, vv); DA_QLOAD(q0); }
    for (int u = F.bid; u < NU; u += F.G) {
        const DaUnit q = da_decode(u);
        LAS unsigned char* lds = F.lds + par * DA_IMG; par ^= 1;
        const int d = q.d, r = q.r, n = q.n, col0 = q.col0;
        const size_t rb = (size_t)q.b * SEQ;
#pragma unroll
        for (int i = 0; i < 4; ++i) { const int c = tid + 512 * i, j = c >> 3, part = c & 7;
            *(LAS u32x4*)(lds + j * DA_KP + part * 16) = kv[i];
            *(LAS u32x4*)(lds + DA_VOFF + j * DA_KP + part * 16) = vv[i]; }
        const int qi = 16 * w + fr; const size_t rowq = rb + (size_t)(128 * n + qi) * d + r;
        bf16x8 qf[2]; qf[0] = qn[0]; qf[1] = qn[1];
        __syncthreads();
        if (u + F.G < NU) { const DaUnit qx = da_decode(u + F.G); da_load(qx, tid, Kg, Vg, kv, vv); DA_QLOAD(qx); }
        f32x4 s[10];
        int frq = fr, wq = w; asm volatile("" : "+v"(frq), "+v"(wq));
#pragma unroll
        for (int kb = 0; kb < 9; ++kb) { const int kbc = (w + kb) < 15 ? (w + kb) : 15; s[kb] = (f32x4){0.f, 0.f, 0.f, 0.f};
#pragma unroll
            for (int ks = 0; ks < 2; ++ks) { const bf16x8 a = *(const LAS bf16x8*)(lds + (16 * kbc + fr) * DA_KP + (32 * ks + 8 * fq) * 2); s[kb] = __builtin_amdgcn_mfma_f32_16x16x32_bf16(a, qf[ks], s[kb], 0, 0, 0); } }
        s[9] = (f32x4){NINF, NINF, NINF, NINF};
        float mx = NINF;
#pragma unroll
        for (int kb = 0; kb < 9; ++kb) { const bool blk_ok = (n > 0) || (wq + kb >= 8);
#pragma unroll
            for (int i = 0; i < 4; ++i) { const int jj = 4 * fq + i; bool ok = blk_ok; if (kb == 0) ok = ok && (frq <= jj); if (kb == 8) ok = ok && (jj <= frq);
                s[kb][i] = ok ? s[kb][i] : NINF; mx = fmaxf(mx, s[kb][i]); } }
        mx = fmaxf(mx, __shfl_xor(mx, 16)); mx = fmaxf(mx, __shfl_xor(mx, 32));
        float sm = 0.f;
#pragma unroll
        for (int kb = 0; kb < 10; ++kb)
#pragma unroll
            for (int i = 0; i < 4; ++i) { s[kb][i] = fexp2(s[kb][i] - mx); sm += s[kb][i]; }
        sm += __shfl_xor(sm, 16); sm += __shfl_xor(sm, 32);
        f32x4 o[4];
#pragma unroll
        for (int eb = 0; eb < 4; ++eb) o[eb] = (f32x4){0.f, 0.f, 0.f, 0.f};
#pragma unroll
        for (int c = 0; c < 5; ++c) { const int ka = (w + 2 * c) < 15 ? (w + 2 * c) : 15, kb2 = (w + 2 * c + 1) < 15 ? (w + 2 * c + 1) : 15;
            const u32x4 pw = pack8(s[2 * c], s[2 * c + 1]); const bf16x8 pb = __builtin_bit_cast(bf16x8, pw);
#pragma unroll
            for (int eb = 0; eb < 4; ++eb) {
                const LAS unsigned char* vr = lds + DA_VOFF + (4 * fq + (fr >> 2)) * DA_KP + (16 * eb + 4 * (fr & 3)) * 2;
                const u32x2 va = __builtin_bit_cast(u32x2, __builtin_amdgcn_ds_read_tr16_b64_v4i16((LAS s16x4*)(vr + 16 * ka * DA_KP)));
                const u32x2 vb = __builtin_bit_cast(u32x2, __builtin_amdgcn_ds_read_tr16_b64_v4i16((LAS s16x4*)(vr + 16 * kb2 * DA_KP)));
                const u32x4 vw = (u32x4){va.x, va.y, vb.x, vb.y};
                o[eb] = __builtin_amdgcn_mfma_f32_16x16x32_bf16(__builtin_bit_cast(bf16x8, vw), pb, o[eb], 0, 0, 0); } }
        const float inv = 1.f / sm;
#pragma unroll
        for (int eb = 0; eb < 4; ++eb) { u32x2 ow; ow.x = cvt_pk_bf16(o[eb][0] * inv, o[eb][1] * inv); ow.y = cvt_pk_bf16(o[eb][2] * inv, o[eb][3] * inv);
            *(u32x2*)(QO + rowq * DW + col0 + 16 * eb + 4 * fq) = ow; }
        if (fq == 0) LSE[rowq * 12 + q.g * 4 + q.h] = mx + __builtin_amdgcn_logf(sm);
    }
    __syncthreads();
#undef DA_QLOAD
}

constexpr int TH_XB = 0, TH_WOFF = 98304;
__device__ __forceinline__ void thin_phase(const Ctx& F, const bf16* AG, const bf16* GB, const bf16* CP, const bf16* OG, const float* LSE,
                                           const float* acw, const float* acb, const float* lng, const float* lnb, const float* ccw, bf16* ACT) {
    const int tid = F.tid, w = F.wave, lane = F.lane;
    LAS unsigned char* lds = F.lds;
    for (int i = tid; i < CAK * CA; i += NTHR) ((LAS bf16*)(lds + TH_WOFF))[i] = (bf16)f2bf(acw[i]);
    f32x4 cb[2], lg[2], lb[2];
#pragma unroll
    for (int q = 0; q < 2; ++q) { cb[q] = *(const f32x4*)(acb + 8 * lane + 4 * q); lg[q] = *(const f32x4*)(lng + 8 * lane + 4 * q); lb[q] = *(const f32x4*)(lnb + 8 * lane + 4 * q); }
    const int cpart = tid & 63;
    const f32x4 wa0 = *(const f32x4*)(ccw + cpart * 8), wa1 = *(const f32x4*)(ccw + cpart * 8 + 4), wb0 = *(const f32x4*)(ccw + CS + cpart * 8), wb1 = *(const f32x4*)(ccw + CS + cpart * 8 + 4),
                wc0 = *(const f32x4*)(ccw + 2 * CS + cpart * 8), wc1 = *(const f32x4*)(ccw + 2 * CS + cpart * 8 + 4);
    for (int s = F.bid; s < M / 64; s += F.G) {
        const int b = s / (SEQ / 64), t0 = (s % (SEQ / 64)) * 64; const size_t rb = (size_t)b * SEQ;
        u32x4 st[12];
#pragma unroll
        for (int i = 0; i < 12; ++i) { const int c = tid + NTHR * i, rr = c >> 6, part = c & 63, tt = t0 - 30 + rr;
            st[i] = (u32x4){0u, 0u, 0u, 0u}; if (c < 94 * 64 && tt >= 0) st[i] = *(const u32x4*)(AG + (rb + tt) * CA + part * 8); }
        u32x4 cg[4], c0w[4], c1w[4], c2w[4];
#define CP_LOAD(i0) do { _Pragma("unroll") for (int i = 0; i < 4; ++i) { const int tok = (tid >> 6) + 8 * ((i0) + i), t = t0 + tok; const size_t row = rb + t; \
            cg[i] = *(const u32x4*)(GB + row * CS + cpart * 8); c0w[i] = *(const u32x4*)(CP + row * CS + cpart * 8); c1w[i] = (u32x4){0u, 0u, 0u, 0u}; c2w[i] = (u32x4){0u, 0u, 0u, 0u}; \
            if (t >= 1) c1w[i] = *(const u32x4*)(CP + (row - 1) * CS + cpart * 8); if (t >= 2) c2w[i] = *(const u32x4*)(CP + (row - 2) * CS + cpart * 8); } } while (0)
#define CP_DO(i0) do { _Pragma("unroll") for (int i = 0; i < 4; ++i) { const int tok = (tid >> 6) + 8 * ((i0) + i); const size_t row = rb + t0 + tok; \
            f32x4 g0, g1, p0, p1, q0, q1, r0, r1; unpack8(cg[i], g0, g1); unpack8(c0w[i], p0, p1); unpack8(c1w[i], q0, q1); unpack8(c2w[i], r0, r1); \
            const f32x4 y0 = g0 * (wc0 * p0 + wb0 * q0 + wa0 * r0), y1 = g1 * (wc1 * p1 + wb1 * q1 + wa1 * r1); \
            *(u32x4*)(ACT + row * KCAT + 768 + cpart * 8) = pack8(y0, y1); } } while (0)
#pragma unroll
        for (int i = 0; i < 12; ++i) { const int c = tid + NTHR * i, rr = c >> 6, part = c & 63; if (c < 94 * 64) *(LAS u32x4*)(lds + TH_XB + rr * 1024 + part * 16) = st[i]; }
        __syncthreads();
        {
            f32x4 acc[8][2];
#pragma unroll
            for (int j = 0; j < 8; ++j) { acc[j][0] = cb[0]; acc[j][1] = cb[1]; }
#pragma nounroll
            for (int k = 0; k < CAK; ++k) { const u32x4 ww = *(const LAS u32x4*)(lds + TH_WOFF + k * 1024 + lane * 16); f32x4 w0, w1; unpack8(ww, w0, w1);
#pragma unroll
                for (int j = 0; j < 8; ++j) { const u32x4 xv = *(const LAS u32x4*)(lds + TH_XB + (8 * w + j + k) * 1024 + lane * 16); f32x4 x0, x1; unpack8(xv, x0, x1); acc[j][0] += w0 * x0; acc[j][1] += w1 * x1; } }
#pragma unroll
            for (int j = 0; j < 8; ++j) { const f32x4 a0 = acc[j][0], a1 = acc[j][1];
                const float mean = wave_sum((a0[0] + a0[1]) + (a0[2] + a0[3]) + (a1[0] + a1[1]) + (a1[2] + a1[3])) * (1.f / CA);
                const f32x4 d0 = a0 - mean, d1 = a1 - mean;
                const float var = wave_sum((d0[0] * d0[0] + d0[1] * d0[1]) + (d0[2] * d0[2] + d0[3] * d0[3]) + (d1[0] * d1[0] + d1[1] * d1[1]) + (d1[2] * d1[2] + d1[3] * d1[3])) * (1.f / CA);
                const float rs = __builtin_amdgcn_rsqf(var + EPS);
                f32x4 y0 = d0 * rs * lg[0] + lb[0], y1 = d1 * rs * lg[1] + lb[1];
#pragma unroll
                for (int q = 0; q < 4; ++q) { y0[q] *= sigmoidf_(y0[q]); y1[q] *= sigmoidf_(y1[q]); }
                *(u32x4*)(ACT + (rb + t0 + 8 * w + j) * KCAT + 8 * lane) = pack8(y0, y1); }
        }
        asm volatile("" ::: "memory");
        CP_LOAD(0);
        CP_DO(0);
        CP_LOAD(4);
        CP_DO(4);
        float ml[4][3]; u32x4 mo[4][3];
#pragma unroll
        for (int i = 0; i < 4; ++i) { const int idx = tid + NTHR * i, tok = idx >> 5, h = (idx >> 3) & 3, part = idx & 7; const size_t row = rb + t0 + tok;
            ml[i][0] = LSE[row * 12 + h]; ml[i][1] = LSE[row * 12 + 4 + h]; ml[i][2] = LSE[row * 12 + 8 + h];
            const bf16* op = OG + row * DW + h * 64 + part * 8; mo[i][0] = *(const u32x4*)op; mo[i][1] = *(const u32x4*)(op + 256); mo[i][2] = *(const u32x4*)(op + 512); }
#pragma unroll
        for (int i = 0; i < 4; ++i) { const int idx = tid + NTHR * i, tok = idx >> 5, h = (idx >> 3) & 3, part = idx & 7; const size_t row = rb + t0 + tok;
            const float mx = fmaxf(ml[i][0], fmaxf(ml[i][1], ml[i][2]));
            float w0 = fexp2(ml[i][0] - mx), w1 = fexp2(ml[i][1] - mx), w2 = fexp2(ml[i][2] - mx); const float inv = 1.f / (w0 + w1 + w2); w0 *= inv; w1 *= inv; w2 *= inv;
            f32x4 a0, a1, b0, b1, e0, e1; unpack8(mo[i][0], a0, a1); unpack8(mo[i][1], b0, b1); unpack8(mo[i][2], e0, e1);
            *(u32x4*)(ACT + row * KCAT + 512 + h * 64 + part * 8) = pack8(a0 * w0 + b0 * w1 + e0 * w2, a1 * w0 + b1 * w1 + e1 * w2); }
        __syncthreads();
#undef CP_LOAD
#undef CP_DO
    }
}

__device__ __forceinline__ void router_phase(const Ctx& F, const bf16* xb, const u64* ss, const float* g, const float* wr, unsigned char* rt, gu32* cnt, unsigned char* x8n) {
    const int tid = F.tid, w = F.wave, lane = F.lane;
    LAS int* hist = (LAS int*)F.lds;
    int* RE = (int*)(rt + RT_E); float* RW = (float*)(rt + RT_W); float* RS = (float*)(rt + RT_RS); int* POS = (int*)(rt + RT_POS); int* BB = (int*)(rt + RT_BB);
    f32x4 wreg[2][8][2];
#pragma unroll
    for (int jj = 0; jj < 2; ++jj) { const int k0 = 8 * lane + 512 * jj; const f32x4 g0 = *(const f32x4*)(g + k0), g1 = *(const f32x4*)(g + k0 + 4);
#pragma unroll
        for (int e = 0; e < 8; ++e) { wreg[jj][e][0] = (f32x4){wr[(k0 + 0) * NE + e] * g0[0], wr[(k0 + 1) * NE + e] * g0[1], wr[(k0 + 2) * NE + e] * g0[2], wr[(k0 + 3) * NE + e] * g0[3]};
                                      wreg[jj][e][1] = (f32x4){wr[(k0 + 4) * NE + e] * g1[0], wr[(k0 + 5) * NE + e] * g1[1], wr[(k0 + 6) * NE + e] * g1[2], wr[(k0 + 7) * NE + e] * g1[3]}; } }
    for (int vb = F.bid; vb < 256; vb += F.G) {
        if (tid < 16) hist[tid] = 0;
        __syncthreads();
        u32x4 xcur[2][2], xnxt[2][2]; u64 scur[2], snxt[2];
#define RT_LOAD(X_, S_, j0_) do { _Pragma("unroll") for (int q_ = 0; q_ < 2; ++q_) { const int t_ = vb * 128 + 16 * w + (j0_) + q_; const u32x4* xr_ = (const u32x4*)(xb + (size_t)t_ * D) + lane; X_[q_][0] = xr_[0]; X_[q_][1] = xr_[64]; S_[q_] = ss[t_]; } } while (0)
        RT_LOAD(xcur, scur, 0);
#pragma unroll
        for (int j = 0; j < 16; ++j) { const int tok = vb * 128 + 16 * w + j;
            if ((j & 1) == 0 && j + 2 < 16) RT_LOAD(xnxt, snxt, j + 2);
            float lg[8];
#pragma unroll
            for (int e = 0; e < 8; ++e) lg[e] = 0.f;
#pragma unroll
            for (int jj = 0; jj < 2; ++jj) { f32x4 v0, v1; unpack8(xcur[j & 1][jj], v0, v1);
#pragma unroll
                for (int e = 0; e < 8; ++e) lg[e] += ((v0[0] * wreg[jj][e][0][0] + v0[1] * wreg[jj][e][0][1]) + (v0[2] * wreg[jj][e][0][2] + v0[3] * wreg[jj][e][0][3]))
                                                   + ((v1[0] * wreg[jj][e][1][0] + v1[1] * wreg[jj][e][1][1]) + (v1[2] * wreg[jj][e][1][2] + v1[3] * wreg[jj][e][1][3])); }
            const float rs = __builtin_amdgcn_rsqf((float)scur[j & 1] * (1.f / (SS_SCALE * D)) + EPS);
#pragma unroll
            for (int jj = 0; jj < 2; ++jj) { f32x4 v0, v1; unpack8(xcur[j & 1][jj], v0, v1); *(u32x2*)(x8n + (size_t)tok * D + 512 * jj + 8 * lane) = pack8_fp8(v0 * rs, v1 * rs); }
            if ((j & 1) == 1) {
#pragma unroll
                for (int q_ = 0; q_ < 2; ++q_) { xcur[q_][0] = xnxt[q_][0]; xcur[q_][1] = xnxt[q_][1]; scur[q_] = snxt[q_]; } }
#pragma unroll
            for (int e = 0; e < 8; ++e) lg[e] = wave_sum(lg[e]) * rs;
            int e1 = 0; float v1 = lg[0];
#pragma unroll
            for (int e = 1; e < 8; ++e) if (lg[e] > v1) { v1 = lg[e]; e1 = e; }
            int e2 = -1; float v2 = -3.0e38f;
#pragma unroll
            for (int e = 0; e < 8; ++e) if (e != e1 && lg[e] > v2) { v2 = lg[e]; e2 = e; }
            const float w1 = 1.f / (1.f + __expf(v2 - v1)), w2 = 1.f - w1;
            if (lane == 0) { const int r1 = atomicAdd((int*)(hist + e1), 1), r2 = atomicAdd((int*)(hist + 8 + e2), 1);
                RE[tok] = e1 | (e2 << 8); RW[2 * tok] = w1; RW[2 * tok + 1] = w2; RS[tok] = rs; POS[2 * tok] = r1; POS[2 * tok + 1] = r2; } }
#undef RT_LOAD
        __syncthreads();
        if (tid < 16) { const int c = hist[tid]; int base = 0; if (c > 0) base = (int)__hip_atomic_fetch_add(cnt + 64 * tid, (unsigned)c, RLX_AGENT); BB[vb * 16 + tid] = base; }
        __syncthreads();
    }
}
__device__ __forceinline__ int tbsel(const pol::MoeTiles& mt, int p, int e) { int t = 0;
#pragma unroll
    for (int k = 0; k < 8; ++k) t = (k == e) ? (p ? mt.tb[1][k] : mt.tb[0][k]) : t;
    return t; }
__device__ __forceinline__ void lists_phase(const Ctx& F, unsigned char* rt, const unsigned* cnt) {
    const int* RE = (const int*)(rt + RT_E); const float* RW = (const float*)(rt + RT_W); const float* RS = (const float*)(rt + RT_RS); const int* POS = (const int*)(rt + RT_POS); const int* BB = (const int*)(rt + RT_BB);
    int* LIST = (int*)(rt + RT_LIST); float* LW = (float*)(rt + RT_LW); float* LR = (float*)(rt + RT_LR); int* SL = (int*)(rt + RT_SL);
    pol::MoeTiles mt; mt.init(cnt);
    const int gt = F.bid * NTHR + F.tid, NT = F.G * NTHR;
    for (int tok = gt; tok < M; tok += NT) { const int ee = RE[tok], vb = tok >> 7; const float rs = RS[tok];
#pragma unroll
        for (int p = 0; p < 2; ++p) { const int e = (ee >> (8 * p)) & 255; const int tb = tbsel(mt, p, e);
            const int slot = p * MOE_ROWS + 256 * tb + BB[vb * 16 + p * 8 + e] + POS[2 * tok + p];
            LIST[slot] = tok; LW[slot] = RW[2 * tok + p]; LR[slot] = rs; SL[p * M + tok] = slot; } }
    for (int idx = gt; idx < 2 * 8 * 256; idx += NT) { const int p = idx >> 11, e = (idx >> 8) & 7, i = idx & 255; const int c = (int)cnt[64 * (p * 8 + e)], rem = c & 255;
        if (rem != 0 && i >= rem) { const int tb = tbsel(mt, p, e); const int slot = p * MOE_ROWS + 256 * (tb + (c >> 8)) + i;
            LIST[slot] = -1; LW[slot] = 0.f; LR[slot] = 0.f; } }
}
#ifndef MK_FFN_UP_FP8
#define MK_FFN_UP_FP8 0
#endif
#ifndef MK_TIMING
#define MK_TIMING 0
#endif
constexpr int RING_BYTES = 131072, XCH_OFF = RING_BYTES, MISC_OFF = XCH_OFF + 16384 + 1024, TS_OFF = MISC_OFF + 256, LDS_BYTES = TS_OFF + 256;
constexpr int NPH = 23;
struct Args { const float* in[29]; float* out; unsigned char* ws; int ph_lo, ph_hi; };

__global__ void __launch_bounds__(NTHR, 2) mk_fwd(Args args) {
    extern __shared__ __attribute__((aligned(16))) unsigned char lds_raw[];
    typedef const __attribute__((address_space(4))) Args* KArgs;
#define KA_ ({ KArgs k_ = (KArgs)__builtin_amdgcn_kernarg_segment_ptr(); asm volatile("" : "+s"(k_)); k_; })
#define LDSB ((LAS unsigned char*)lds_raw)
#define MK_CTX(F) Ctx F; F.lds = LDSB; F.tid = threadIdx.x; asm volatile("" : "+v"(F.tid)); F.lane = F.tid & 63; F.wave = __builtin_amdgcn_readfirstlane(F.tid >> 6); \
    F.G = gridDim.x; F.bid = blockIdx.x; F.gw = F.bid * NWAVES + F.wave; F.NGW = F.G * NWAVES;
    {   volatile LAS unsigned* MISC = (volatile LAS unsigned*)(LDSB + MISC_OFF);
        if (threadIdx.x < 64) MISC[threadIdx.x] = 0u;
        __syncthreads();
        if (args.ph_hi - args.ph_lo > 1) (void)xcd_barrier_post((unsigned*)(args.ws + WS_CTL) + CW_BAR, MISC + 8); }
#if MK_TIMING
#define STAMP(i) do { if (((i) == MK_TB0 || (i) == MK_TB1) && threadIdx.x == 0) ((volatile LAS unsigned long long*)(LDSB + TS_OFF))[(i) == MK_TB0 ? 0 : 1] = __builtin_amdgcn_s_memrealtime(); } while (0)
    STAMP(0);
#else
#define STAMP(i) do { } while (0)
#endif
#define PHASE_ARGS MK_CTX(F) KArgs ka = KA_; unsigned char* ws = ka->ws; unsigned char* R1 = ws + WS_R1; (void)R1;
#define INP(k) (ka->in[k])
#ifndef MK_MASK
#define MK_MASK 0xFFFFFFFFu
#endif
#define EN(s) (((MK_MASK) >> (s)) & 1u)
#define IN(k) ({ KArgs q_ = KA_; q_->ph_lo <= (k) && (k) < q_->ph_hi; })
#define SEAM(k) do { if (IN(k) && IN((k) + 1)) { XcdBarrier b2_; b2_.bar = (unsigned*)(KA_->ws + WS_CTL) + CW_BAR; b2_.x = xb_xcc_id(); b2_.st = (volatile LAS unsigned*)(LDSB + MISC_OFF) + 8; xcd_barrier(b2_); STAMP((k) + 1); } } while (0)
#define ring LDSB
#ifndef MK_STAG_Z
#define MK_STAG_Z 0
#endif
#define STAGGER(ticks) do { if ((ticks) > 0 && (blockIdx.x & 1)) { const unsigned long long t0_ = __builtin_amdgcn_s_memrealtime(); while (__builtin_amdgcn_s_memrealtime() - t0_ < (unsigned long long)(ticks)) __builtin_amdgcn_s_sleep(8); } } while (0)
#define SSP ((u64*)(ws + WS_SS))
#define XBP ((bf16*)(ws + WS_XB))
#define OUTP (ka->out)

    if (EN(0) && IN(0)) { PHASE_ARGS int rot = 0;
        for (int l = 0; l < 2; ++l) {
            unsigned char* wl = ws + WS_W + (size_t)l * W_LAYER;
            if (NZB) tr_matrix<1>(F, rot, INP(3) + (size_t)l * D * NIN, nullptr, D, NZB, NIN, (bf16*)(wl + W_WIN), D, 0, INP(2) + l * D);
            tr_matrix<3, true>(F, rot, INP(3) + (size_t)l * D * NIN, nullptr, D, NZ8, NIN, (bf16*)(wl + W_WIN8), D, 0, INP(2) + l * D);
            tr_matrix<0>(F, rot, INP(9) + (size_t)l * CA * D, nullptr, CA, D, D, (bf16*)(wl + W_WCAT), KCAT, 0, nullptr);
            tr_matrix<0>(F, rot, INP(10) + (size_t)l * DO * D, nullptr, DO, D, D, (bf16*)(wl + W_WCAT), KCAT, 512, nullptr);
            tr_matrix<0>(F, rot, INP(12) + (size_t)l * CS * D, nullptr, CS, D, D, (bf16*)(wl + W_WCAT), KCAT, 768, nullptr);
            tr_matrix<0>(F, rot, INP(13) + (size_t)l * D * D, nullptr, D, D, D, (bf16*)(wl + W_WO), D, 0, nullptr);
            bf16* wkv = (bf16*)(R1 + R_WKV) + (size_t)l * 2048 * D;
            tr_matrix<0>(F, rot, INP(17) + (size_t)l * D * D, nullptr, D, D, D, wkv, D, 0, nullptr);
            tr_matrix<0>(F, rot, INP(18) + (size_t)l * D * D, nullptr, D, D, D, wkv + (size_t)D * D, D, 0, nullptr);
            tr_matrix<0>(F, rot, INP(19) + (size_t)l * D * D, nullptr, D, D, D, (bf16*)(R1 + R_WOT) + (size_t)l * D * D, D, 0, nullptr);
            cv_rows(F, INP(16) + (size_t)l * D * D, (bf16*)(R1 + R_WQ) + (size_t)l * D * D, D, INP(14) + l * D, CX);
            rows_rmsnorm_bf16(F, INP(1), INP(15) + l * D, (bf16*)(R1 + R_MN) + (size_t)l * 512 * D, NB * MEM);
            float* bz = (float*)(ws + WS_BZ) + l * NIN; const float* bi = INP(4) + l * NIN;
            for (int n = F.bid * NTHR + F.tid; n < NIN; n += F.G * NTHR) bz[n] = bi[n < NZB ? zmapB(n) : zmap8(n - NZB)];
        }
        #if MK_FFN_UP_FP8
        tr_matrix<2, true>(F, rot, INP(21), INP(22), D, 2 * DFF, DFF, (bf16*)(ws + WS_WFF + WFF_W13), D, 0, INP(20));
#else
        tr_matrix<2>(F, rot, INP(21), INP(22), D, 2 * DFF, DFF, (bf16*)(ws + WS_WFF + WFF_W13), D, 0, INP(20));
#endif
#if MK_FFN_DOWN_FP8
        tr_matrix<0, true>(F, rot, INP(23), nullptr, DFF, D, D, (bf16*)(ws + WS_WFF + WFF_W2), DFF, 0, nullptr);
#else
        tr_matrix<0>(F, rot, INP(23), nullptr, DFF, D, D, (bf16*)(ws + WS_WFF + WFF_W2), DFF, 0, nullptr);
#endif
        rows_raw_ss(F, INP(0), XBP, ws + WS_X8, SSP);
    }
    SEAM(0);
    for (int l = 0; l < 2; ++l) {
        const int pb = l == 0 ? 1 : 10;
#define WL (ws + WS_W + (size_t)l * W_LAYER)
#define AGP ((bf16*)(R1 + R_AG))
#define GBP ((bf16*)(R1 + R_GB))
#define CPP ((bf16*)(R1 + R_CP))
#define QP ((bf16*)(R1 + R_Q))
#define KP ((bf16*)(R1 + R_K))
#define VP ((bf16*)(R1 + R_V))
#define GTP ((const unsigned char*)(R1 + R_G))
#define ACTP ((bf16*)(R1 + R_ACT))
#define MRGP ((bf16*)(R1 + R_MRG))
#define PBP ((bf16*)(R1 + R_P))
#define LSEP ((float*)(ws + WS_LSE))
#define SSA (SSP + (size_t)(3 * l) * M)
        if (EN(4) && IN(pb + 0)) { PHASE_ARGS
            STAGGER(MK_STAG_Z);
            {   const float* bzg = (const float*)(ws + WS_BZ) + l * NIN; LAS bf16* bzl = (LAS bf16*)(LDSB + XCH_OFF + 1024);
                for (int i = F.tid; i < NIN; i += NTHR) bzl[i] = (bf16)f2bf(bzg[i]);
                __syncthreads(); }
            {   pol::PolZ8 p; p.init(M / 256, NZ8 / 256, F.G, F.bid);
                p.A = (const char*)(ws + WS_X8); p.Bt = (const char*)(WL + W_WIN8); p.ss = SSA; p.bzl = (LAS bf16*)(LDSB + XCH_OFF + 1024) + NZB; p.R1 = R1; p.rsl = (LAS float*)(LDSB + XCH_OFF); p.cpm = -1;
                pg8::gemm_phase<pol::PolZ8, true>(ring, p); }
            if (NZB) {   pol::PolZB p; p.init(M / 256, NZB / 256, F.G, F.bid);
                p.A = (const char*)XBP; p.Bt = (const char*)(WL + W_WIN); p.ss = SSA; p.bzl = (LAS bf16*)(LDSB + XCH_OFF + 1024); p.R1 = R1; p.rsl = (LAS float*)(LDSB + XCH_OFF); p.cpm = -1;
                pg8::gemm_phase<pol::PolZB, true>(ring, p); }
            if (l == 0 && EN(1)) {
                pol::PolPlain p; p.init(4, 8, F.G, F.bid >= F.G / 2 ? F.bid - F.G / 2 : (1 << 20));
                p.A = (const char*)(R1 + R_MN); p.Bt = (const char*)(R1 + R_WKV); p.C = (char*)(R1 + R_KM); p.lda_ = 2048; p.ldb_ = 2048; p.ldc_ = 4096; p.nt_ = 16;
                p.mper = 2; p.n0 = 1; p.n1 = 1; p.a0 = p.a1 = 0; p.a2 = (size_t)512 * 2048; p.b0 = p.b1 = 0; p.b2 = (size_t)2048 * 2048; p.c0 = p.c1 = 0; p.c2 = (size_t)512 * 4096;
                pg8::gemm_phase<pol::PolPlain, true>(ring, p); }
        }
        SEAM(pb + 0);
        if (EN(5) && IN(pb + 1)) { PHASE_ARGS dil_attn_phase(F, QP, KP, VP, LSEP);
            if (l == 0) {
                __syncthreads();
                if (EN(2)) {   pol::PolPlain8 p; p.init(16, 4, F.G, F.bid >= F.G / 2 ? F.bid - F.G / 2 : (1 << 20));
                    p.A = (const char*)(R1 + R_KM); p.Bt = (const char*)(R1 + R_WQ); p.C = (char*)(ws + WS_WQK); p.lda_ = 4096; p.ldb_ = 2048; p.ldc_ = 1024; p.nt_ = 4;
                    p.mper = 1; p.n0 = 4; p.n1 = 2; p.a0 = 512; p.a1 = (size_t)256 * 4096; p.a2 = (size_t)512 * 4096; p.b0 = 512; p.b1 = 0; p.b2 = (size_t)D * 2048;
                    p.c0 = (size_t)256 * 1024; p.c1 = (size_t)D * 1024; p.c2 = (size_t)2 * D * 1024;
                    pg8::gemm_phase<pol::PolPlain8, true>(ring, p); }
                if (EN(3)) {   pol::PolPlain8 p; p.init(64, 1, F.G, F.bid >= F.G / 2 + 64 ? F.bid - F.G / 2 - 64 : (1 << 20));
                    p.A = (const char*)(R1 + R_WOT); p.Bt = (const char*)(R1 + R_KM) + 2048; p.C = (char*)(ws + WS_WVO); p.lda_ = 2048; p.ldb_ = 4096; p.ldc_ = 1024; p.nt_ = 4;
                    p.mper = 4; p.n0 = 4; p.n1 = 2; p.a0 = 512; p.a1 = 0; p.a2 = (size_t)D * 2048; p.b0 = 512; p.b1 = (size_t)256 * 4096; p.b2 = (size_t)512 * 4096;
                    p.c0 = 256; p.c1 = (size_t)D * 1024; p.c2 = (size_t)2 * D * 1024;
                    pg8::gemm_phase<pol::PolPlain8, true>(ring, p); }
            }
        }
        SEAM(pb + 1);
        if (EN(6) && IN(pb + 2)) { PHASE_ARGS thin_phase(F, AGP, GBP, CPP, QP, LSEP, INP(5) + l * CAK * CA, INP(6) + l * CA, INP(7) + l * CA, INP(8) + l * CA, INP(11) + l * 3 * CS, ACTP); }
        SEAM(pb + 2);
        if (EN(7) && IN(pb + 3)) { PHASE_ARGS
            pol::PolMerge p; p.init(M / 256, 4, F.G, F.bid);
            p.A = (const char*)ACTP; p.Bt = (const char*)(WL + W_WCAT); p.Gt = GTP; p.MRG = MRGP;
            pg8::gemm_phase<pol::PolMerge, true>(ring, p);
        }
        SEAM(pb + 3);
        if (EN(8) && IN(pb + 4)) { PHASE_ARGS
            if (l == 1) { int rot = 0;
                for (int e = 0; e < NE; ++e) {
                    tr_matrix<2, true>(F, rot, INP(25) + (size_t)e * D * MFF, INP(26) + (size_t)e * D * MFF, D, 2 * MFF, MFF, (bf16*)(R1 + R_MW13 + (size_t)e * 2 * MFF * D), D, 0, INP(20) + D);
                    tr_matrix<0, true>(F, rot, INP(27) + (size_t)e * MFF * D, nullptr, MFF, D, D, (bf16*)(R1 + R_MW2 + (size_t)e * D * MFF), MFF, 0, nullptr);
                }
                __syncthreads();
            }
            pol::PolRes p; p.init(M / 256, 4, F.G, F.bid);
            p.A = (const char*)MRGP; p.Bt = (const char*)(WL + W_WO); p.b_batch = 0; p.K = D; p.XB = XBP; p.ssn = SSA + (size_t)M; p.X8 = ws + WS_X8; p.ascale = 1.f;
            pg8::gemm_phase<pol::PolRes, true>(ring, p);
        }
        SEAM(pb + 4);
        if (EN(9) && IN(pb + 5)) { PHASE_ARGS
            pol::PolXS p; p.init(M / 256, 4, F.G, F.bid);
            p.A = (const char*)(ws + WS_X8); p.Bt = (const char*)(ws + WS_WQK) + (size_t)l * 2 * D * 1024; p.b_batch = (size_t)D * 1024; p.ss = SSA + (size_t)M; p.P = R1 + R_P; p.xch = (LAS float*)(F.lds + XCH_OFF); p.parity = 0;
            pg8::gemm_phase<pol::PolXS, true>(ring, p);
        }
        SEAM(pb + 5);
        if (EN(10) && IN(pb + 6)) { PHASE_ARGS
            pol::PolRes8 p; p.init(M / 256, 4, F.G, F.bid);
            p.A = (const char*)(R1 + R_P); p.Bt = (const char*)(ws + WS_WVO) + (size_t)l * 2 * D * 1024; p.b_batch = (size_t)D * 1024; p.K = D; p.XB = XBP; p.ssn = SSA + (size_t)2 * M; p.X8 = (l == 0 && MK_FFN_UP_FP8) ? ws + WS_X8 : nullptr; p.ascale = W8_INV * W8_INV;
            pg8::gemm_phase<pol::PolRes8, true>(ring, p);
        }
        SEAM(pb + 6);
        if (l == 0) {
            if (EN(11) && IN(pb + 7)) { PHASE_ARGS
#if MK_FFN_UP_FP8
                typedef pol::PolUp PolUpX; const char* upA = (const char*)(ws + WS_X8);
#else
                typedef pol::PolUpB PolUpX; const char* upA = (const char*)XBP;
#endif
                PolUpX p; p.init(M / 256, 2 * DFF / 256, F.G, F.bid);
                p.A = upA;
                p.out16 = !MK_FFN_DOWN_FP8; p.rsl = (LAS float*)(LDSB + XCH_OFF); p.cpm = -1;
                p.Bt = (const char*)(ws + WS_WFF + WFF_W13); p.ss = SSA + (size_t)2 * M; p.U = R1 + R_U;
                pg8::gemm_phase<PolUpX, true>(ring, p);
            }
            SEAM(pb + 7);
            if (EN(12) && IN(pb + 8)) { PHASE_ARGS
#if MK_FFN_DOWN_FP8
                typedef pol::PolRes8 PolDownX; const float dsc = W8_INV;
#else
                typedef pol::PolRes PolDownX; const float dsc = 1.f;
#endif
                PolDownX p; p.init(M / 256, 4, F.G, F.bid);
                p.A = (const char*)(R1 + R_U); p.Bt = (const char*)(ws + WS_WFF + WFF_W2); p.b_batch = 0; p.K = DFF; p.XB = XBP; p.ssn = SSP + (size_t)3 * M; p.X8 = ws + WS_X8; p.ascale = dsc;
                pg8::gemm_phase<PolDownX, true>(ring, p);
            }
            SEAM(pb + 8);
        } else {
#define RTP (ws + WS_RT)
#define CNTP ((gu32*)(ws + WS_CTL) + CW_CNT)
            if (EN(13) && IN(pb + 7)) { PHASE_ARGS router_phase(F, XBP, SSA + (size_t)2 * M, INP(20) + D, INP(24), RTP, CNTP, ws + WS_X8); }
            SEAM(pb + 7);
            if (EN(14) && IN(pb + 8)) { PHASE_ARGS lists_phase(F, RTP, (const unsigned*)CNTP); }
            SEAM(pb + 8);
            if (EN(15) && IN(pb + 9)) { PHASE_ARGS
                unsigned char* rt = RTP;
                pol::PolMoeUp p; p.mt.init((const unsigned*)CNTP); p.init(p.mt.ntiles(), 2 * MFF / 256, F.G, F.bid);
                p.A = (const char*)(ws + WS_X8); p.Bt = (const char*)(R1 + R_MW13); p.list = (const int*)(rt + RT_LIST); p.lr = (const float*)(rt + RT_LR); p.U = R1 + R_U;
                pg8::gemm_phase<pol::PolMoeUp, true>(ring, p);
            }
            SEAM(pb + 9);
#define VCU ((F.G % 8 == 0) ? (F.bid % 8) * (F.G / 8) + F.bid / 8 : F.bid)
            if (EN(16) && IN(pb + 10)) { PHASE_ARGS
                unsigned char* rt = RTP;
                pol::PolMoeDown p; p.mt.init((const unsigned*)CNTP); p.init(p.mt.ntiles(), 4, F.G, VCU);
                const int nun = p.mt.ntiles() * 4, rem = nun % F.G; p.l_off = 0; p.l_end = nun - rem;
                p.A = (const char*)(R1 + R_U); p.Bt = (const char*)(R1 + R_MW2); p.lw = (const float*)(rt + RT_LW); p.Y = (bf16*)(R1 + R_Y);
                pg8::gemm_phase<pol::PolMoeDown, true>(ring, p);
            }
            SEAM(pb + 10);
            if (EN(16) && IN(pb + 11)) { PHASE_ARGS
                unsigned char* rt = RTP; const int vcu = VCU;
                pol::PolMoeDown p; p.mt.init((const unsigned*)CNTP); p.init(p.mt.ntiles(), 4, F.G, vcu);
                const int nun = p.mt.ntiles() * 4, rem = nun % F.G, late_tile = (nun - rem) >> 2; p.l_off = nun - rem; p.l_end = nun;
                p.A = (const char*)(R1 + R_U); p.Bt = (const char*)(R1 + R_MW2); p.lw = (const float*)(rt + RT_LW); p.Y = (bf16*)(R1 + R_Y);
                if (vcu < rem) pg8::gemm_phase<pol::PolMoeDown, true>(ring, p);
                else rows_final(F, (vcu - rem) * NWAVES + F.wave, (F.G - rem) * NWAVES, XBP, (const bf16*)(R1 + R_Y), (const int*)(rt + RT_SL), (const float*)(rt + RT_W), INP(28), OUTP, p.mt.tb[0][8], late_tile, 0);
            }
            SEAM(pb + 11);
        }
    }
    if (EN(17) && IN(22)) { PHASE_ARGS
        pol::MoeTiles mt; mt.init((const unsigned*)((gu32*)(ws + WS_CTL) + CW_CNT)); const int nun = mt.ntiles() * 4, rem = nun % F.G, late_tile = (nun - rem) >> 2;
        if (rem) rows_final(F, F.gw, F.NGW, XBP, (const bf16*)(R1 + R_Y), (const int*)(ws + WS_RT + RT_SL), (const float*)(ws + WS_RT + RT_W), INP(28), OUTP, mt.tb[0][8], late_tile, 1); }
#if MK_TIMING
    {
        volatile LAS unsigned long long* ts = (volatile LAS unsigned long long*)(LDSB + TS_OFF);
        if (blockIdx.x == 0 && threadIdx.x == 0) { const unsigned long long now = __builtin_amdgcn_s_memrealtime(); if (MK_TB1 == NPH) ts[1] = now;
            const unsigned long long target = now + (ts[1] - ts[0]) * 100ull;
            while (__builtin_amdgcn_s_memrealtime() < target) __builtin_amdgcn_s_sleep(32); }
    }
#endif
#undef IN
#undef SEAM
}
#if MK_DEBUG
namespace dbg {
constexpr int TN = 2304, NS = 32, NCK = 33;
__device__ const int SAMP[NS] = {0, 1, 2, 3, 29, 30, 31, 32, 63, 64, 127, 128, 129, 255, 256, 511, 512, 640, 1023, 1024, 1500, 2047, 2048, 2049, 2050, 2079, 2080, 2175, 2176, 2177, 2200, 2303};
__host__ __device__ constexpr int ck_w(int ck) { const int k = ck % 16; return ck == 32 ? 1024 : (k == 0 ? 512 : k <= 3 ? 768 : k <= 5 ? 512 : k == 6 ? 3072 : k == 7 ? 512 : k <= 12 ? 1024 : k == 13 ? 256 : k == 14 ? 512 : 0); }
__host__ __device__ inline size_t ck_off(int ck) { size_t o = 0; for (int i = 0; i < ck; ++i) o += (size_t)NS * ck_w(i); return o; }
constexpr size_t O_X = 0, O_HN = O_X + (size_t)TN * 1024, O_Z = O_HN + (size_t)TN * 1024, O_A0 = O_Z + (size_t)TN * NIN, O_A1 = O_A0 + (size_t)TN * 512, O_A2 = O_A1 + (size_t)TN * 512,
    O_SC = O_A2 + (size_t)TN * 512, O_ST = O_SC + (size_t)TN * 12 * 129, O_OG = O_ST + (size_t)TN * 12 * 2, O_O = O_OG + (size_t)TN * 768, O_C2 = O_O + (size_t)TN * 256,
    O_YA = O_C2 + (size_t)TN * 512, O_YB = O_YA + (size_t)TN * 1024, O_YC = O_YB + (size_t)TN * 1024, O_MRG = O_YC + (size_t)TN * 1024, O_T = O_MRG + (size_t)TN * 1024,
    O_MEMN = O_T + (size_t)TN * 1024, O_KM = O_MEMN + 256 * 1024, O_VM = O_KM + 256 * 1024, O_XS = O_VM + 256 * 1024, O_XO = O_XS + (size_t)TN * 1024,
    O_FA = O_XO + (size_t)TN * 1024, O_FB = O_FA + (size_t)TN * 3584 * 2, O_LG = O_FB + (size_t)TN * 3584 * 2, O_RT = O_LG + (size_t)TN * 8, O_END = O_RT + (size_t)TN * 4;
static_assert(O_END * 4 <= 432 * MiB, "oracle buffers fit R1");

__global__ void k_copy(const float* s, float* d, size_t n) { for (size_t i = blockIdx.x * (size_t)blockDim.x + threadIdx.x; i < n; i += (size_t)gridDim.x * blockDim.x) d[i] = s[i]; }
__global__ void k_rms(const float* x, const float* g, float* o, int rows) {
    __shared__ float red[256];
    for (int r = blockIdx.x; r < rows; r += gridDim.x) { float s = 0.f; for (int c = threadIdx.x; c < 1024; c += 256) { const float v = x[(size_t)r * 1024 + c]; s += v * v; }
        red[threadIdx.x] = s; __syncthreads(); for (int o2 = 128; o2 > 0; o2 >>= 1) { if ((int)threadIdx.x < o2) red[threadIdx.x] += red[threadIdx.x + o2]; __syncthreads(); }
        const float rs = 1.f / sqrtf(red[0] / 1024.f + EPS); __syncthreads();
        for (int c = threadIdx.x; c < 1024; c += 256) o[(size_t)r * 1024 + c] = x[(size_t)r * 1024 + c] * rs * g[c]; }
}
__global__ void k_gemm(const float* A, int lda, const float* W, int ldw, const float* bias, float* C, int ldc, int rows, int N, int K) {
    const size_t tot = (size_t)rows * N;
    for (size_t i = blockIdx.x * (size_t)blockDim.x + threadIdx.x; i < tot; i += (size_t)gridDim.x * blockDim.x) { const int r = (int)(i / N), n = (int)(i % N); float acc = 0.f;
        for (int k = 0; k < K; ++k) acc += A[(size_t)r * lda + k] * W[(size_t)k * ldw + n];
        C[(size_t)r * ldc + n] = acc + (bias ? bias[n] : 0.f); }
}
__device__ inline float sigm(float x) { return 1.f / (1.f + expf(-x)); }
__global__ void k_glu(const float* z, float* a0) { for (int i = blockIdx.x * blockDim.x + threadIdx.x; i < TN * 512; i += gridDim.x * blockDim.x) { const int t = i / 512, c = i % 512; a0[i] = z[(size_t)t * NIN + c] * sigm(z[(size_t)t * NIN + 512 + c]); } }
__global__ void k_conv31(const float* a0, const float* w, const float* b, float* a1) { for (int i = blockIdx.x * blockDim.x + threadIdx.x; i < TN * 512; i += gridDim.x * blockDim.x) { const int t = i / 512, c = i % 512; float s = b[c];
        for (int k = 0; k < 31; ++k) { const int tt = t - 30 + k; if (tt >= 0) s += w[k * 512 + c] * a0[(size_t)tt * 512 + c]; } a1[i] = s; } }
__global__ void k_ln_silu(const float* a1, const float* g, const float* b, float* a2) {
    __shared__ float red[256];
    for (int r = blockIdx.x; r < TN; r += gridDim.x) { const float v0 = a1[(size_t)r * 512 + threadIdx.x], v1 = a1[(size_t)r * 512 + 256 + threadIdx.x];
        red[threadIdx.x] = v0 + v1; __syncthreads(); for (int o2 = 128; o2 > 0; o2 >>= 1) { if ((int)threadIdx.x < o2) red[threadIdx.x] += red[threadIdx.x + o2]; __syncthreads(); }
        const float mu = red[0] / 512.f; __syncthreads(); const float d0 = v0 - mu, d1 = v1 - mu;
        red[threadIdx.x] = d0 * d0 + d1 * d1; __syncthreads(); for (int o2 = 128; o2 > 0; o2 >>= 1) { if ((int)threadIdx.x < o2) red[threadIdx.x] += red[threadIdx.x + o2]; __syncthreads(); }
        const float rs = 1.f / sqrtf(red[0] / 512.f + EPS); __syncthreads();
        const float y0 = d0 * rs * g[threadIdx.x] + b[threadIdx.x], y1 = d1 * rs * g[256 + threadIdx.x] + b[256 + threadIdx.x];
        a2[(size_t)r * 512 + threadIdx.x] = y0 * sigm(y0); a2[(size_t)r * 512 + 256 + threadIdx.x] = y1 * sigm(y1); }
}
__global__ void k_scores(const float* z, float* sc) {
    for (int i = blockIdx.x * blockDim.x + threadIdx.x; i < TN * 12 * 129; i += gridDim.x * blockDim.x) { const int j = i % 129, gh = (i / 129) % 12, t = i / (129 * 12), g = gh / 4; const int d = g == 0 ? 1 : (g == 1 ? 4 : 16);
        const int tk = t - j * d; float s = -__builtin_inff();
        if (tk >= 0) { s = 0.f; for (int e = 0; e < 64; ++e) s += z[(size_t)t * NIN + OFF_Q + gh * 64 + e] * z[(size_t)tk * NIN + OFF_K + gh * 64 + e]; s *= 0.125f; }
        sc[i] = s; }
}
__global__ void k_attn_stats(const float* sc, float* st) { for (int i = blockIdx.x * blockDim.x + threadIdx.x; i < TN * 12; i += gridDim.x * blockDim.x) { float mx = -__builtin_inff(); for (int j = 0; j < 129; ++j) mx = fmaxf(mx, sc[(size_t)i * 129 + j]);
        float den = 0.f; for (int j = 0; j < 129; ++j) den += expf(sc[(size_t)i * 129 + j] - mx); st[2 * i] = mx; st[2 * i + 1] = den; } }
__global__ void k_attn_out(const float* sc, const float* st, const float* z, float* og) {
    for (int i = blockIdx.x * blockDim.x + threadIdx.x; i < TN * 768; i += gridDim.x * blockDim.x) { const int t = i / 768, c = i % 768, gh = c / 64, g = gh / 4; const int d = g == 0 ? 1 : (g == 1 ? 4 : 16);
        const float mx = st[2 * (t * 12 + gh)], den = st[2 * (t * 12 + gh) + 1]; float o = 0.f;
        for (int j = 0; j < 129; ++j) { const int tk = t - j * d; if (tk >= 0) o += expf(sc[((size_t)t * 12 + gh) * 129 + j] - mx) / den * z[(size_t)tk * NIN + OFF_V + c]; }
        og[i] = o; }
}
__global__ void k_attn_merge(const float* og, const float* st, float* o) { for (int i = blockIdx.x * blockDim.x + threadIdx.x; i < TN * 256; i += gridDim.x * blockDim.x) { const int t = i / 256, c = i % 256, h = c / 64;
        float l[3], mx = -__builtin_inff(); for (int g = 0; g < 3; ++g) { l[g] = st[2 * (t * 12 + g * 4 + h)] + logf(st[2 * (t * 12 + g * 4 + h) + 1]); mx = fmaxf(mx, l[g]); }
        float den = 0.f, acc = 0.f; for (int g = 0; g < 3; ++g) { const float w = expf(l[g] - mx); den += w; acc += w * og[(size_t)t * 768 + g * 256 + c]; } o[i] = acc / den; } }
__global__ void k_shortconv(const float* z, const float* w, float* c2) { for (int i = blockIdx.x * blockDim.x + threadIdx.x; i < TN * 512; i += gridDim.x * blockDim.x) { const int t = i / 512, c = i % 512; float s = 0.f;
        for (int k = 0; k < 3; ++k) { const int tt = t - 2 + k; if (tt >= 0) s += w[k * 512 + c] * z[(size_t)tt * NIN + OFF_CC + c] * z[(size_t)tt * NIN + OFF_CH + c]; } c2[i] = z[(size_t)t * NIN + OFF_CB + c] * s; } }
__global__ void k_merge(const float* z, const float* ya, const float* yb, const float* yc, float* m) { for (int i = blockIdx.x * blockDim.x + threadIdx.x; i < TN * 1024; i += gridDim.x * blockDim.x) { const int t = i / 1024, c = i % 1024;
        m[i] = sigm(z[(size_t)t * NIN + OFF_G + c]) * ya[i] + sigm(z[(size_t)t * NIN + OFF_G + 1024 + c]) * yb[i] + sigm(z[(size_t)t * NIN + OFF_G + 2048 + c]) * yc[i]; } }
__global__ void k_add(float* x, const float* y, size_t n) { for (size_t i = blockIdx.x * (size_t)blockDim.x + threadIdx.x; i < n; i += (size_t)gridDim.x * blockDim.x) x[i] += y[i]; }
__global__ void k_xscores(const float* q, const float* km, float* s) {
    for (int i = blockIdx.x * blockDim.x + threadIdx.x; i < TN * 1024; i += gridDim.x * blockDim.x) { const int t = i / 1024, h = (i / 256) % 4, key = i % 256; float a = 0.f;
        for (int e = 0; e < 256; ++e) a += q[(size_t)t * 1024 + h * 256 + e] * km[(size_t)key * 1024 + h * 256 + e]; s[i] = a * 0.0625f; } }
__global__ void k_softmax256(float* s, int rows) { for (int r = blockIdx.x * blockDim.x + threadIdx.x; r < rows; r += gridDim.x * blockDim.x) { float mx = -__builtin_inff(); for (int j = 0; j < 256; ++j) mx = fmaxf(mx, s[(size_t)r * 256 + j]);
        float den = 0.f; for (int j = 0; j < 256; ++j) den += expf(s[(size_t)r * 256 + j] - mx); for (int j = 0; j < 256; ++j) s[(size_t)r * 256 + j] = expf(s[(size_t)r * 256 + j] - mx) / den; } }
__global__ void k_xout(const float* p, const float* vm, float* o) { for (int i = blockIdx.x * blockDim.x + threadIdx.x; i < TN * 1024; i += gridDim.x * blockDim.x) { const int t = i / 1024, n = i % 1024, h = n / 256; float a = 0.f;
        for (int key = 0; key < 256; ++key) a += p[(size_t)t * 1024 + h * 256 + key] * vm[(size_t)key * 1024 + n]; o[i] = a; } }
__global__ void k_swiglu(const float* a, const float* b, float* u, size_t n) { for (size_t i = blockIdx.x * (size_t)blockDim.x + threadIdx.x; i < n; i += (size_t)gridDim.x * blockDim.x) u[i] = a[i] * sigm(a[i]) * b[i]; }
__global__ void k_top2(const float* lg, float* rt) { for (int t = blockIdx.x * blockDim.x + threadIdx.x; t < TN; t += gridDim.x * blockDim.x) { int e1 = 0; float v1 = lg[t * 8]; for (int e = 1; e < 8; ++e) if (lg[t * 8 + e] > v1) { v1 = lg[t * 8 + e]; e1 = e; }
        int e2 = -1; float v2 = -3.0e38f; for (int e = 0; e < 8; ++e) if (e != e1 && lg[t * 8 + e] > v2) { v2 = lg[t * 8 + e]; e2 = e; }
        const float w1 = 1.f / (1.f + expf(v2 - v1)); rt[t * 4] = (float)e1; rt[t * 4 + 1] = (float)e2; rt[t * 4 + 2] = w1; rt[t * 4 + 3] = 1.f - w1; } }
__global__ void k_moe_up(const float* hn, const float* rt, const float* w1, const float* w3, float* u) {
    for (size_t i = blockIdx.x * (size_t)blockDim.x + threadIdx.x; i < (size_t)TN * 2 * MFF; i += (size_t)gridDim.x * blockDim.x) { const int j = (int)(i % MFF), p = (int)((i / MFF) % 2), t = (int)(i / (2 * MFF)); const int e = (int)rt[t * 4 + p];
        const float* a1 = w1 + (size_t)e * D * MFF + j; const float* a3 = w3 + (size_t)e * D * MFF + j; float a = 0.f, b = 0.f;
        for (int k = 0; k < D; ++k) { const float h = hn[(size_t)t * D + k]; a += h * a1[(size_t)k * MFF]; b += h * a3[(size_t)k * MFF]; } u[i] = a * sigm(a) * b; } }
__global__ void k_moe_down(const float* u, const float* rt, const float* w2, float* y) { for (int i = blockIdx.x * blockDim.x + threadIdx.x; i < TN * D; i += gridDim.x * blockDim.x) { const int t = i / D, n = i % D; float acc = 0.f;
        for (int p = 0; p < 2; ++p) { const int e = (int)rt[t * 4 + p]; float a = 0.f; for (int j = 0; j < MFF; ++j) a += u[((size_t)t * 2 + p) * MFF + j] * w2[((size_t)e * MFF + j) * D + n]; acc += rt[t * 4 + 2 + p] * a; } y[i] = acc; } }
__global__ void k_sample(const float* src, int ld, int col0, int width, float scale, float* gold, int mode, int col1) {
    for (int i = blockIdx.x * blockDim.x + threadIdx.x; i < NS * width; i += gridDim.x * blockDim.x) { const int s = i / width, c = i % width; const float v = src[(size_t)SAMP[s] * ld + col0 + c];
        gold[i] = mode == 0 ? v * scale : (mode == 1 ? sigm(v) : v * src[(size_t)SAMP[s] * ld + col1 + c]); } }
__global__ void k_check(const void* mainp, int is_bf16, int ld, int col0, const float* gold, int gld, int gcol0, int width, float* chk) {
    __shared__ float rd[256], rg[256]; float d2 = 0.f, g2 = 0.f;
    for (int i = threadIdx.x; i < NS * width; i += 256) { const int s = i / width, c = i % width; const size_t o = (size_t)SAMP[s] * ld + col0 + c;
        const float v = is_bf16 ? bf2f(((const bf16*)mainp)[o]) : ((const float*)mainp)[o]; const float g = gold[(size_t)s * gld + gcol0 + c]; const float df = v - g; d2 += (df == df) ? df * df : 1.0e30f; g2 += g * g; }
    rd[threadIdx.x] = d2; rg[threadIdx.x] = g2; __syncthreads();
    for (int o2 = 128; o2 > 0; o2 >>= 1) { if ((int)threadIdx.x < o2) { rd[threadIdx.x] += rd[threadIdx.x + o2]; rg[threadIdx.x] += rg[threadIdx.x + o2]; } __syncthreads(); }
    if (threadIdx.x == 0) *chk = sqrtf(rd[0] / fmaxf(rg[0], 1e-30f));
}
__global__ void k_encode(float* out, const float* chk, float tol) {
    int bad = -1; for (int k = 0; k < NCK; ++k) if ((k == 32 || (k % 16) < 13) && !(chk[k] <= tol)) { bad = k; break; }
    if (bad < 0) return;
    const float c = exp2f((float)(bad + 1));
    for (size_t i = blockIdx.x * (size_t)blockDim.x + threadIdx.x; i < (size_t)M * D; i += (size_t)gridDim.x * blockDim.x) out[i] = c;
}
__global__ void k_detail(float* out, const void* mainp, int ld, int col0, const float* gold, int gld, int gcol0, int ntile, float tol, float* res) {
    __shared__ int first, cnt; if (threadIdx.x == 0) { first = 1 << 30; cnt = 0; } __syncthreads();
    for (int p = threadIdx.x; p < NS * ntile; p += blockDim.x) { const int s2 = p / ntile, t = p % ntile; float d2 = 0.f, g2 = 0.f;
        for (int c = 0; c < 256; ++c) { const float v = bf2f(((const bf16*)mainp)[(size_t)SAMP[s2] * ld + col0 + t * 256 + c]), g = gold[(size_t)s2 * gld + gcol0 + t * 256 + c]; const float df = v - g; d2 += (df == df) ? df * df : 1e30f; g2 += g * g; }
        if (!(sqrtf(d2 / fmaxf(g2, 1e-30f)) <= tol)) { atomicMin(&first, p); atomicAdd(&cnt, 1); } }
    __syncthreads();
    if (threadIdx.x == 0) { res[0] = (float)first; res[1] = (float)cnt; }
}
__global__ void k_detail_fill(float* out, const float* res) {
    const int first = (int)res[0], cnt = (int)res[1]; if (cnt == 0) return;
    const int cls = cnt <= 1 ? 0 : (cnt <= 4 ? 1 : (cnt <= 16 ? 2 : 3));
    const float c = exp2f(0.5f * (float)(first + 1)) * (1.f + 0.1f * cls);
    for (size_t i = blockIdx.x * (size_t)blockDim.x + threadIdx.x; i < (size_t)M * D; i += (size_t)gridDim.x * blockDim.x) out[i] = c;
}
}

static void dbg_oracle(const Args& a, hipStream_t st) {
    using namespace dbg;
    float* O = (float*)(a.ws + WS_R1); float* gold = (float*)(a.ws + WS_DBG);
    const dim3 g(1024), b(256);
#define SAMPLE(src, ld, c0, ck, sc) k_sample<<<64, 256, 0, st>>>(src, ld, c0, ck_w(ck), sc, gold + ck_off(ck), 0, 0)
#define SAMPLEM(src, ld, c0, ck, mode, c1) k_sample<<<64, 256, 0, st>>>(src, ld, c0, ck_w(ck), 1.f, gold + ck_off(ck), mode, c1)
    k_copy<<<g, b, 0, st>>>(a.in[0], O + O_X, (size_t)TN * 1024);
    for (int l = 0; l < 2; ++l) {
        const int cb = 16 * l;
        k_rms<<<g, b, 0, st>>>(O + O_X, a.in[2] + l * 1024, O + O_HN, TN);
        k_gemm<<<g, b, 0, st>>>(O + O_HN, 1024, a.in[3] + (size_t)l * 1024 * NIN, NIN, a.in[4] + l * NIN, O + O_Z, NIN, TN, NIN, 1024);
        k_glu<<<g, b, 0, st>>>(O + O_Z, O + O_A0);
        k_conv31<<<g, b, 0, st>>>(O + O_A0, a.in[5] + l * 31 * 512, a.in[6] + l * 512, O + O_A1);
        k_ln_silu<<<g, b, 0, st>>>(O + O_A1, a.in[7] + l * 512, a.in[8] + l * 512, O + O_A2);
        k_scores<<<g, b, 0, st>>>(O + O_Z, O + O_SC);
        k_attn_stats<<<g, b, 0, st>>>(O + O_SC, O + O_ST);
        k_attn_out<<<g, b, 0, st>>>(O + O_SC, O + O_ST, O + O_Z, O + O_OG);
        k_attn_merge<<<g, b, 0, st>>>(O + O_OG, O + O_ST, O + O_O);
        k_shortconv<<<g, b, 0, st>>>(O + O_Z, a.in[11] + l * 3 * 512, O + O_C2);
        SAMPLE(O + O_A0, 512, 0, cb + 0, 1.f); SAMPLE(O + O_Z, NIN, OFF_Q, cb + 1, C2); SAMPLE(O + O_Z, NIN, OFF_K, cb + 2, 1.f); SAMPLE(O + O_Z, NIN, OFF_V, cb + 3, 1.f); SAMPLE(O + O_Z, NIN, OFF_CB, cb + 4, 1.f);
        SAMPLEM(O + O_Z, NIN, OFF_CC, cb + 5, 2, OFF_CH); SAMPLEM(O + O_Z, NIN, OFF_G, cb + 6, 1, 0);
        SAMPLE(O + O_A2, 512, 0, cb + 7, 1.f); SAMPLE(O + O_O, 256, 0, cb + 13, 1.f); SAMPLE(O + O_C2, 512, 0, cb + 14, 1.f);
        k_gemm<<<g, b, 0, st>>>(O + O_A2, 512, a.in[9] + (size_t)l * 512 * 1024, 1024, nullptr, O + O_YA, 1024, TN, 1024, 512);
        k_gemm<<<g, b, 0, st>>>(O + O_O, 256, a.in[10] + (size_t)l * 256 * 1024, 1024, nullptr, O + O_YB, 1024, TN, 1024, 256);
        k_gemm<<<g, b, 0, st>>>(O + O_C2, 512, a.in[12] + (size_t)l * 512 * 1024, 1024, nullptr, O + O_YC, 1024, TN, 1024, 512);
        k_merge<<<g, b, 0, st>>>(O + O_Z, O + O_YA, O + O_YB, O + O_YC, O + O_MRG);
        SAMPLE(O + O_MRG, 1024, 0, cb + 8, 1.f);
        k_gemm<<<g, b, 0, st>>>(O + O_MRG, 1024, a.in[13] + (size_t)l * 1024 * 1024, 1024, nullptr, O + O_T, 1024, TN, 1024, 1024);
        k_add<<<g, b, 0, st>>>(O + O_X, O + O_T, (size_t)TN * 1024);
        SAMPLE(O + O_X, 1024, 0, cb + 9, 1.f);
        k_rms<<<g, b, 0, st>>>(O + O_X, a.in[14] + l * 1024, O + O_HN, TN);
        k_gemm<<<g, b, 0, st>>>(O + O_HN, 1024, a.in[16] + (size_t)l * 1024 * 1024, 1024, nullptr, O + O_T, 1024, TN, 1024, 1024);
        k_rms<<<g, b, 0, st>>>(a.in[1], a.in[15] + l * 1024, O + O_MEMN, 256);
        k_gemm<<<g, b, 0, st>>>(O + O_MEMN, 1024, a.in[17] + (size_t)l * 1024 * 1024, 1024, nullptr, O + O_KM, 1024, 256, 1024, 1024);
        k_gemm<<<g, b, 0, st>>>(O + O_MEMN, 1024, a.in[18] + (size_t)l * 1024 * 1024, 1024, nullptr, O + O_VM, 1024, 256, 1024, 1024);
        k_xscores<<<g, b, 0, st>>>(O + O_T, O + O_KM, O + O_XS);
        k_softmax256<<<g, b, 0, st>>>(O + O_XS, TN * 4);
        SAMPLE(O + O_XS, 1024, 0, cb + 10, 1.f);
        k_xout<<<g, b, 0, st>>>(O + O_XS, O + O_VM, O + O_XO);
        k_gemm<<<g, b, 0, st>>>(O + O_XO, 1024, a.in[19] + (size_t)l * 1024 * 1024, 1024, nullptr, O + O_T, 1024, TN, 1024, 1024);
        k_add<<<g, b, 0, st>>>(O + O_X, O + O_T, (size_t)TN * 1024);
        SAMPLE(O + O_X, 1024, 0, cb + 11, 1.f);
        k_rms<<<g, b, 0, st>>>(O + O_X, a.in[20] + l * 1024, O + O_HN, TN);
        if (l == 0) {
            k_gemm<<<g, b, 0, st>>>(O + O_HN, 1024, a.in[21], DFF, nullptr, O + O_FA, DFF, TN, DFF, 1024);
            k_gemm<<<g, b, 0, st>>>(O + O_HN, 1024, a.in[22], DFF, nullptr, O + O_FB, DFF, TN, DFF, 1024);
            k_swiglu<<<g, b, 0, st>>>(O + O_FA, O + O_FB, O + O_FA, (size_t)TN * DFF);
            k_gemm<<<g, b, 0, st>>>(O + O_FA, DFF, a.in[23], 1024, nullptr, O + O_T, 1024, TN, 1024, DFF);
        } else {
            k_gemm<<<g, b, 0, st>>>(O + O_HN, 1024, a.in[24], 8, nullptr, O + O_LG, 8, TN, 8, 1024);
            k_top2<<<g, b, 0, st>>>(O + O_LG, O + O_RT);
            k_moe_up<<<g, b, 0, st>>>(O + O_HN, O + O_RT, a.in[25], a.in[26], O + O_FA);
            k_moe_down<<<g, b, 0, st>>>(O + O_FA, O + O_RT, a.in[27], O + O_T);
        }
        k_add<<<g, b, 0, st>>>(O + O_X, O + O_T, (size_t)TN * 1024);
        SAMPLE(O + O_X, 1024, 0, cb + 12, 1.f);
    }
    k_rms<<<g, b, 0, st>>>(O + O_X, a.in[28], O + O_HN, TN);
    SAMPLE(O + O_HN, 1024, 0, 32, 1.f);
#undef SAMPLE
#undef SAMPLEM
}
static void dbg_check(const Args& a, int ph, hipStream_t st) {
    using namespace dbg;
    const unsigned char* R1 = a.ws + WS_R1; const float* gold = (const float*)(a.ws + WS_DBG); float* chk = (float*)(a.ws + WS_CTL) + CW_CHK;
#define CHECK(ptr, isb, ld, c0, ck) k_check<<<1, 256, 0, st>>>(ptr, isb, ld, c0, gold + ck_off(ck), ck_w(ck), 0, ck_w(ck), chk + (ck))
    for (int l = 0; l < 2; ++l) { const int pb = l == 0 ? 1 : 10, cb = 16 * l;
        if (ph == pb + 0) { CHECK(R1 + R_AG, 1, 512, 0, cb + 0); CHECK(R1 + R_Q, 1, 768, 0, cb + 1); CHECK(R1 + R_K, 1, 768, 0, cb + 2); CHECK(R1 + R_V, 1, 768, 0, cb + 3); CHECK(R1 + R_GB, 1, 512, 0, cb + 4);
                            CHECK(R1 + R_CP, 1, 512, 0, cb + 5);
 }
        if (ph == pb + 2) { CHECK(R1 + R_ACT, 1, KCAT, 0, cb + 7); CHECK(R1 + R_ACT, 1, KCAT, 512, cb + 13); CHECK(R1 + R_ACT, 1, KCAT, 768, cb + 14); }
        if (ph == pb + 3) { CHECK(R1 + R_MRG, 1, 1024, 0, cb + 8); }
        if (ph == pb + 4) { CHECK(a.ws + WS_XB, 1, 1024, 0, cb + 9); }
        if (ph == pb + 5) {   }
        if (ph == pb + 6) { CHECK(a.ws + WS_XB, 1, 1024, 0, cb + 11); }
        if (l == 0 && ph == pb + 8) { CHECK(a.ws + WS_XB, 1, 1024, 0, cb + 12); }

    }
    if (ph == 1) k_detail<<<1, 128, 0, st>>>(a.out, R1 + R_G, 3072, 0, gold + ck_off(6), 3072, 0, 4, 0.03f, chk + 50);
    if (ph == 22) CHECK(a.out, 0, 1024, 0, 32);
#undef CHECK
}
static void dbg_encode(const Args& a, hipStream_t st) { dbg::k_encode<<<1024, 256, 0, st>>>(a.out, (const float*)(a.ws + WS_CTL) + CW_CHK, 0.03f);
#ifdef MK_DETAIL
    dbg::k_detail_fill<<<1024, 256, 0, st>>>(a.out, (const float*)(a.ws + WS_CTL) + CW_CHK + 50);
#endif
}
#endif
extern "C" void kernel_launch(void* const* d_in, const int* in_sizes, int n_in, void* d_out, int out_size, void* d_ws, size_t ws_size, hipStream_t stream) {
    static int grid = 0;
    if (grid == 0) {
        if (n_in != 29 || in_sizes[0] != M * D || out_size != M * D || ws_size < WS_END) {
            fprintf(stderr, "kernel_launch: built for 29 inputs, x/out of %d floats, >= %zu bytes of workspace; got n_in %d, in0 %d, out %d, ws %zu; nothing launched\n", M * D, (size_t)WS_END, n_in, n_in > 0 ? in_sizes[0] : -1, out_size, ws_size);
            grid = -1; return; }
        int dev = 0, cus = 0, per_cu = 0;
        if (hipGetDevice(&dev) != hipSuccess || hipDeviceGetAttribute(&cus, hipDeviceAttributeMultiprocessorCount, dev) != hipSuccess) { grid = -1; return; }
        if (hipFuncSetAttribute((const void*)mk_fwd, hipFuncAttributeMaxDynamicSharedMemorySize, LDS_BYTES) != hipSuccess) { fprintf(stderr, "kernel_launch: hipFuncSetAttribute failed\n"); grid = -1; return; }
        if (hipOccupancyMaxActiveBlocksPerMultiprocessor(&per_cu, (const void*)mk_fwd, NTHR, LDS_BYTES) != hipSuccess || per_cu < 1) { fprintf(stderr, "kernel_launch: occupancy query reports %d blocks per CU\n", per_cu); per_cu = 1; }
        (void)hipGetLastError();
        grid = cus;
    }
    if (grid < 0) return;
    if (hipMemsetAsync((char*)d_ws + WS_CTL, 0, CTL_ZERO_BYTES, stream) != hipSuccess) return;
    Args a{};
    for (int i = 0; i < 29; ++i) a.in[i] = (const float*)d_in[i];
    a.out = (float*)d_out; a.ws = (unsigned char*)d_ws;
#if MK_DEBUG
    dbg_oracle(a, stream);
#endif
#if MK_ONE_LAUNCH && !MK_DEBUG
    a.ph_lo = 0; a.ph_hi = NPH;
    hipLaunchKernelGGL(mk_fwd, dim3(grid), dim3(NTHR), LDS_BYTES, stream, a);
#else
    for (int ph = 0; ph < NPH; ++ph) {
        a.ph_lo = ph; a.ph_hi = ph + 1;
        hipLaunchKernelGGL(mk_fwd, dim3(grid), dim3(NTHR), LDS_BYTES, stream, a);
#if MK_DEBUG
        dbg_check(a, ph, stream);
#endif
    }
#endif
#if MK_DEBUG
    dbg_encode(a, stream);
#endif
}
```

```cpp
#define MK_FFN_UP_FP8 1
#include <hip/hip_runtime.h>
#include <cstdio>
#include <cstdint>

#ifndef MK_DEBUG
#define MK_DEBUG 0
#endif
#ifndef MK_FFN_DOWN_FP8
#define MK_FFN_DOWN_FP8 1
#endif
#ifndef MK_Z_ALL_FP8
#define MK_Z_ALL_FP8 0
#endif
#ifndef MK_ONE_LAUNCH
#define MK_ONE_LAUNCH 1
#endif

#define GAS __attribute__((address_space(1)))
#define LAS __attribute__((address_space(3)))
typedef unsigned short bf16;
typedef short bf16x8 __attribute__((ext_vector_type(8)));
typedef short s16x4 __attribute__((ext_vector_type(4)));
typedef float f32x4 __attribute__((ext_vector_type(4)));
typedef float f32x2 __attribute__((ext_vector_type(2)));
typedef unsigned u32x4 __attribute__((ext_vector_type(4)));
typedef unsigned u32x2 __attribute__((ext_vector_type(2)));
typedef GAS unsigned gu32;

constexpr int D = 1024, NB = 2, SEQ = 16384, M = NB * SEQ, MEM = 256;
constexpr int NIN = 7936, OFF_A = 0, OFF_Q = 1024, OFF_K = 1792, OFF_V = 2560, OFF_CB = 3328, OFF_CC = 3840, OFF_CH = 4352, OFF_G = 4864;
constexpr int CA = 512, CAK = 31, DW = 768, DO = 256, CS = 512, KCAT = 1280;
constexpr int DFF = 2816, NE = 8, MFF = 3584;
constexpr float EPS = 1e-6f, LOG2E = 1.4426950408889634f;
constexpr float C2 = 0.125f * LOG2E;
constexpr float CX = 0.0625f * LOG2E;
constexpr int NWAVES = 8, NTHR = 512;
constexpr int MAXRT = 136;
constexpr int MOE_ROWS = MAXRT * 256;

constexpr size_t MiB = 1u << 20;
constexpr size_t WS_CTL = 0, CTL_ZERO_BYTES = 4 * MiB;
constexpr size_t WS_SS = 2 * MiB;
constexpr size_t WS_WQK = 4 * MiB;
constexpr size_t WS_WVO = 8 * MiB;
constexpr size_t WS_LSE = 12 * MiB;
constexpr size_t WS_RT = 14 * MiB;
constexpr size_t WS_BZ = 16 * MiB;
constexpr size_t WS_W = 17 * MiB;
constexpr size_t W_LAYER = 20 * MiB;
constexpr size_t W_WIN = 0, W_WIN8 = MK_Z_ALL_FP8 ? 0 : 6 * MiB, W_WCAT = 15872 * 1024, W_WO = W_WCAT + 2560 * 1024;
constexpr int NZB = MK_Z_ALL_FP8 ? 0 : 10 * 256, NZ8 = MK_Z_ALL_FP8 ? 31 * 256 : 21 * 256;
constexpr size_t WS_WFF = WS_W + 2 * W_LAYER;
constexpr size_t WFF_W13 = 0, WFF_W2 = 11 * MiB;
constexpr size_t WS_XB = WS_WFF + (MK_FFN_DOWN_FP8 ? 14 : 17) * MiB;
constexpr size_t WS_X8 = WS_XB + 64 * MiB;
constexpr size_t WS_R1 = WS_X8 + 32 * MiB;
constexpr size_t WS_DBG = WS_R1 + 432 * MiB;
constexpr size_t R_AG = 0, R_GB = 32 * MiB, R_CP = 64 * MiB, R_Q = 96 * MiB, R_K = 144 * MiB, R_V = 192 * MiB, R_G = 240 * MiB;
constexpr size_t R_ACT = R_K;
constexpr size_t R_MRG = 0;
constexpr size_t R_P = 0;
constexpr size_t R_U = 0;
constexpr size_t R_MW13 = 336 * MiB, R_MW2 = 404 * MiB;
constexpr size_t R_Y = 240 * MiB;
constexpr size_t R_PT = 400 * MiB, R_MN = R_PT, R_KM = R_PT + 2 * MiB, R_VM = R_PT + 4 * MiB, R_WQ = R_PT + 6 * MiB, R_WKV = R_PT + 10 * MiB, R_WOT = R_PT + 18 * MiB;
constexpr size_t WS_END = WS_R1 + 432 * MiB;
static_assert(R_MW13 + 56 * MiB <= R_MW2 && R_MW2 + 28 * MiB <= 432 * MiB && R_Y + (size_t)2 * MOE_ROWS * D * 2 <= R_MW2 && (size_t)2 * MOE_ROWS * MFF <= R_Y, "R1 map");
constexpr size_t RT_E = 0;
constexpr size_t RT_W = 128 * 1024;
constexpr size_t RT_RS = 384 * 1024;
constexpr size_t RT_POS = 512 * 1024;
constexpr size_t RT_BB = 768 * 1024;
constexpr size_t RT_LIST = 800 * 1024;
constexpr size_t RT_LW = RT_LIST + 2 * MOE_ROWS * 4;
constexpr size_t RT_LR = RT_LW + 2 * MOE_ROWS * 4;
constexpr size_t RT_SL = RT_LR + 2 * MOE_ROWS * 4;
static_assert(RT_SL + 2 * M * 4 <= 2 * MiB, "routing tables");
constexpr int CW_TMO = 0, CW_BAR = 4096, CW_CNT = 8192  , CW_CHK = 12288;

#define RLX_AGENT __ATOMIC_RELAXED, __HIP_MEMORY_SCOPE_AGENT
#define LDS_WAIT() asm volatile("s_waitcnt lgkmcnt(0)" ::: "memory")
#define VM_WAIT() asm volatile("s_waitcnt vmcnt(0)" ::: "memory")
__device__ __forceinline__ unsigned f2bf(float f) { unsigned u = __builtin_bit_cast(unsigned, f); return (u + 0x7fffu + ((u >> 16) & 1u)) >> 16; }
__device__ __forceinline__ unsigned pk2(float lo, float hi) { return f2bf(lo) | (f2bf(hi) << 16); }
typedef __bf16 bf16x2_t __attribute__((ext_vector_type(2)));
__device__ __forceinline__ unsigned cvt_pk_bf16(float lo, float hi) { const f32x2 v = {lo, hi}; const bf16x2_t b = __builtin_convertvector(v, bf16x2_t); return __builtin_bit_cast(unsigned, b); }
__device__ __forceinline__ float bflo(unsigned u) { return __builtin_bit_cast(float, u << 16); }
__device__ __forceinline__ float bfhi(unsigned u) { return __builtin_bit_cast(float, u & 0xffff0000u); }
__device__ __forceinline__ float bf2f(bf16 b) { return __builtin_bit_cast(float, (unsigned)b << 16); }
__device__ __forceinline__ float fexp2(float x) { return __builtin_amdgcn_exp2f(x); }
__device__ __forceinline__ float frcp(float x) { return __builtin_amdgcn_rcpf(x); }
__device__ __forceinline__ float sigmoidf_(float x) { return frcp(1.f + fexp2(-LOG2E * x)); }
__device__ __forceinline__ float wave_sum(float v) {
#pragma unroll
    for (int o = 1; o < 64; o <<= 1) v += __shfl_xor(v, o);
    return v;
}
typedef unsigned long long u64;
constexpr float SS_SCALE = 16777216.f;
__device__ __forceinline__ float row_rstd(const u64* ss, int row) { return __builtin_amdgcn_rsqf((float)ss[row] * (1.f / (SS_SCALE * D)) + EPS); }
__device__ __forceinline__ void row_ss_add(u64* ss, int row, float sq) { __hip_atomic_fetch_add(ss + row, (u64)(sq * SS_SCALE), RLX_AGENT); }
__device__ __forceinline__ u32x4 pack8(const f32x4& a, const f32x4& b) { u32x4 w; w.x = cvt_pk_bf16(a[0], a[1]); w.y = cvt_pk_bf16(a[2], a[3]); w.z = cvt_pk_bf16(b[0], b[1]); w.w = cvt_pk_bf16(b[2], b[3]); return w; }
typedef int v4i_t __attribute__((ext_vector_type(4)));
typedef int v8i_t __attribute__((ext_vector_type(8)));
constexpr float W8_SCALE = 64.f, W8_INV = 1.f / 64.f;
__device__ __forceinline__ unsigned pk4_fp8(float a, float b, float c, float d) { unsigned r = 0u; r = (unsigned)__builtin_amdgcn_cvt_pk_fp8_f32(a, b, (int)r, false); r = (unsigned)__builtin_amdgcn_cvt_pk_fp8_f32(c, d, (int)r, true); return r; }
__device__ __forceinline__ float clamp8(float v) { return __builtin_amdgcn_fmed3f(v, -448.f, 448.f); }
__device__ __forceinline__ u32x2 pack8_fp8(const f32x4& a, const f32x4& b) { u32x2 w; w.x = pk4_fp8(clamp8(a[0]), clamp8(a[1]), clamp8(a[2]), clamp8(a[3])); w.y = pk4_fp8(clamp8(b[0]), clamp8(b[1]), clamp8(b[2]), clamp8(b[3])); return w; }
__device__ __forceinline__ unsigned gate_q(float g) { const float q = fminf(fmaxf(g * 255.f + 0.5f, 1.f), 255.f); return (unsigned)q; }
__device__ __forceinline__ u32x2 pack8_gate(const f32x4& a, const f32x4& b) { u32x2 w; w.x = gate_q(a[0]) | (gate_q(a[1]) << 8) | (gate_q(a[2]) << 16) | (gate_q(a[3]) << 24); w.y = gate_q(b[0]) | (gate_q(b[1]) << 8) | (gate_q(b[2]) << 16) | (gate_q(b[3]) << 24); return w; }
__device__ __forceinline__ void unpack8_gate(const u32x2& w, f32x4& a, f32x4& b) { a = (f32x4){(float)(w.x & 0xffu), (float)((w.x >> 8) & 0xffu), (float)((w.x >> 16) & 0xffu), (float)(w.x >> 24)}; b = (f32x4){(float)(w.y & 0xffu), (float)((w.y >> 8) & 0xffu), (float)((w.y >> 16) & 0xffu), (float)(w.y >> 24)}; }
__device__ __forceinline__ unsigned gate_off(int pm, int br, int pn, int wid, int ai, int m, int bj, int lane) { return ((unsigned)((pm * 3 + br) * 4 + pn) << 16) + (unsigned)(((((wid * 2 + ai) * 4 + m) * 2 + bj) << 9) + lane * 8); }
__device__ __forceinline__ void unpack8(const u32x4& w, f32x4& a, f32x4& b) { a = (f32x4){bflo(w.x), bfhi(w.x), bflo(w.y), bfhi(w.y)}; b = (f32x4){bflo(w.z), bfhi(w.z), bflo(w.w), bfhi(w.w)}; }

#define XB_TMO      128
#define XB_XCNT(j)  (256  + 64 * (j))
#define XB_XSUB(j)  (1280 + 64 * (j))
#define XB_XGEN(j)  (2304 + 64 * (j))
#define XB_TOP      3328
#define XB_TOPGEN   3392
#define XCD_BAR_WORDS 3456
#define XB_SPIN_CAP (1u << 18)
__device__ __forceinline__ unsigned xb_ld(unsigned* p)              { return __hip_atomic_load(p, __ATOMIC_RELAXED, __HIP_MEMORY_SCOPE_AGENT); }
__device__ __forceinline__ unsigned xb_add(unsigned* p, unsigned v) { return __hip_atomic_fetch_add(p, v, __ATOMIC_RELAXED, __HIP_MEMORY_SCOPE_AGENT); }
__device__ __forceinline__ unsigned xb_xcc_id() { return (unsigned)__builtin_amdgcn_s_getreg((3 << 11) | 20) & 0xFu; }
#define XB_SPIN(cond, bar) do { unsigned _sp = 0; while (cond) { __builtin_amdgcn_s_sleep(1); \
    if ((++_sp & 255u) == 0u) { if (xb_ld(&(bar)[XB_TMO])) break; if (_sp > XB_SPIN_CAP) { atomicAdd(&(bar)[XB_TMO], 1u); break; } } } } while (0)
struct XcdBarrier { unsigned* bar; unsigned x; volatile LAS unsigned* st; };
__device__ __forceinline__ XcdBarrier xcd_barrier_post(unsigned* bar, volatile LAS unsigned* st) {
    XcdBarrier b; b.bar = bar; b.x = xb_xcc_id(); b.st = st;
    if (threadIdx.x == 0) (void)xb_add(&bar[XB_XCNT(b.x)], 1u);
    return b;
}
__device__ __forceinline__ void xcd_barrier_complete(unsigned* bar, unsigned x, unsigned& nloc, unsigned& nx) {
    const unsigned G = gridDim.x * gridDim.y * gridDim.z;
    unsigned sum, cnt, mine, sp = 0u;
    for (;;) {
        sum = 0u; cnt = 0u; mine = 0u;
#pragma unroll
        for (unsigned j = 0; j < 16; ++j) { const unsigned c = xb_ld(&bar[XB_XCNT(j)]); sum += c; cnt += (c > 0u) ? 1u : 0u; mine = (j == x) ? c : mine; }
        if (sum == G) break;
        __builtin_amdgcn_s_sleep(1);
        if ((++sp & 255u) == 0u) { if (xb_ld(&bar[XB_TMO])) break; if (sp > XB_SPIN_CAP) { atomicAdd(&bar[XB_TMO], 1u); break; } }
    }
    nloc = mine > 0u ? mine : 1u; nx = cnt > 0u ? cnt : 1u;
}
__device__ __forceinline__ void xcd_barrier(const XcdBarrier& b) {
    asm volatile("s_waitcnt vmcnt(0)" ::: "memory");
    __syncthreads();
    if (threadIdx.x == 0) {
        unsigned* bar = b.bar;
        __builtin_amdgcn_s_waitcnt(0);
        unsigned nloc = b.st[0], nx = b.st[1];
        if (nloc == 0u) { xcd_barrier_complete(bar, b.x, nloc, nx); b.st[0] = nloc; b.st[1] = nx; }
        const unsigned old = xb_add(&bar[XB_XSUB(b.x)], 1u);
        const unsigned gen = old / nloc;
        if (old + 1u == (gen + 1u) * nloc) {
            __builtin_amdgcn_fence(__ATOMIC_RELEASE, "agent");
            asm volatile("s_waitcnt vmcnt(0)" ::: "memory");
            const unsigned og = xb_add(&bar[XB_TOP], 1u);
            const unsigned tg = og / nx;
            if (og + 1u == (tg + 1u) * nx) xb_add(&bar[XB_TOPGEN], 1u);
            else XB_SPIN(xb_ld(&bar[XB_TOPGEN]) == tg, bar);
            __builtin_amdgcn_fence(__ATOMIC_ACQUIRE, "agent");
            xb_add(&bar[XB_XGEN(b.x)], 1u);
            asm volatile("s_waitcnt vmcnt(0)" ::: "memory");
        } else {
            XB_SPIN(xb_ld(&bar[XB_XGEN(b.x)]) == gen, bar);
            __builtin_amdgcn_fence(__ATOMIC_ACQUIRE, "agent");
            asm volatile("s_waitcnt vmcnt(0)" ::: "memory");
        }
    }
    __syncthreads();
}

#ifndef MK_AUX_A
#define MK_AUX_A 0
#endif
#ifndef MK_AUX_B
#define MK_AUX_B 0
#endif
#ifndef MK_NT
#define MK_NT 1
#endif
#if MK_NT
#define NT_ST(T, addr, val) __builtin_nontemporal_store((val), (T*)(addr))
#define NT_LD(ptr) __builtin_nontemporal_load(ptr)
#else
#define NT_ST(T, addr, val) (*(T*)(addr) = (val))
#define NT_LD(ptr) (*(ptr))
#endif
#define PL_ST(T, addr, val) (*(T*)(addr) = (val))
#ifndef MK_NT_GLD
#define MK_NT_GLD 0
#endif
#ifndef MK_NT_RLD
#define MK_NT_RLD 0
#endif
#if MK_NT_GLD
#define GATE_LD(p) NT_LD(p)
#else
#define GATE_LD(p) (*(p))
#endif
#if MK_NT_RLD
#define RES_LD(p) NT_LD(p)
#else
#define RES_LD(p) (*(p))
#endif
#ifndef MK_NT_GATE
#define MK_NT_GATE 1
#endif
#if MK_NT_GATE
#define GATE_ST NT_ST
#else
#define GATE_ST PL_ST
#endif
#ifndef MK_NT_VAL
#define MK_NT_VAL 1
#endif
#if MK_NT_VAL
#define VAL_ST NT_ST
#else
#define VAL_ST PL_ST
#endif
#ifndef MK_NT_QKV
#define MK_NT_QKV 0
#endif
#if MK_NT_QKV
#define QKV_ST NT_ST
#else
#define QKV_ST PL_ST
#endif
namespace pg8 {
constexpr int BM = 256, BK = 64, HALF = 128, HTB = HALF * BK * 2, STAGE_BYTES = 8 * HTB, NXCD = 8, WGM = 8;
__host__ __device__ __forceinline__ int lds_byte(int r, int c) { const int st = (r >> 4) * 2 + (c >> 5), rr = r & 15, cc = c & 31, ob = rr * 64 + cc * 2; return st * 1024 + (ob ^ (((ob >> 9) & 1) << 5)); }
__host__ __device__ __forceinline__ void stage_rc(int b, int& R, int& C) { const int st = b / 1024, sb = b % 1024, swz = sb ^ (((sb >> 9) & 1) << 5); R = (st >> 1) * 16 + swz / 64; C = (st & 1) * 32 + (swz % 64) / 2; }
__host__ __device__ __forceinline__ int perm32(int rho) { const int n = rho >> 4, i = rho & 15; return 8 * (i >> 2) + 4 * n + (i & 3); }
struct Unit { int pm, pn; };
typedef f32x4 Acc[2][2][4][2];

struct Order {
    int nM, nN, nwg, G, c;
    __device__ __forceinline__ void init(int nM_, int nN_, int G_, int c_) { nM = nM_; nN = nN_; nwg = nM * nN; G = G_; c = c_; }
    __device__ __forceinline__ bool next(int i, Unit& u) const {
        const long L = (long)i * G + c; if (L >= nwg) return false;
        int wgid = (int)L; { const int q = nwg / NXCD, r = nwg % NXCD, xcd = wgid % NXCD, off = wgid / NXCD; wgid = (xcd < r ? xcd * (q + 1) : r * (q + 1) + (xcd - r) * q) + off; }
        const int nig = WGM * nN, gid = wgid / nig, fm = gid * WGM, gsz = (nM - fm) < WGM ? (nM - fm) : WGM;
        u.pm = fm + ((wgid % nig) % gsz); u.pn = (wgid % nig) / gsz; return true;
    }
};

template <class P, bool ALIGN_EPI>
__device__ __forceinline__ void gemm_phase(LAS unsigned char* lds, const P& p) {
    int tid = threadIdx.x; asm volatile("" : "+v"(tid));
    const int wid = __builtin_amdgcn_readfirstlane(tid >> 6), lane = tid & 63, wr = wid >> 2, wc = wid & 3, fr = lane & 15, fq = lane >> 4;
    const int nt = p.nt();
    const unsigned lda = (unsigned)p.lda(), ldb = (unsigned)p.ldb();
    int RA[2]; unsigned CA2[2], voffA[2], voffB[2];
#pragma unroll
    for (int i = 0; i < 2; ++i) { int R, C; stage_rc(tid * 16 + i * 8192, R, C); RA[i] = R; CA2[i] = (unsigned)C * 2u; voffA[i] = (unsigned)R * lda + (unsigned)C * 2u; const int Rb = (R & ~31) + perm32(R & 31); voffB[i] = (unsigned)Rb * ldb + (unsigned)C * 2u; }
    const size_t hA = P::GATHER ? (size_t)0 : (size_t)HALF * lda;
    const size_t kstep = (size_t)(BK * 2);
    const size_t hB = (size_t)HALF * ldb;
    const unsigned ldsw = (unsigned)wid * 1024u;
    const int aoff = lds_byte(wr * 64 + fr, fq * 8), boff = lds_byte(wc * 32 + fr, fq * 8);
#define PG8_SA(b, h) (((b) * 2 + (h)) * HTB)
#define PG8_SB(b, h) ((4 + (b) * 2 + (h)) * HTB)
#define PG8_STAGE_A(bufoff, gbase, off2) do { _Pragma("unroll") for (int _i = 0; _i < 2; ++_i) \
        __builtin_amdgcn_global_load_lds((const unsigned*)((const char*)(gbase) + (off2)[_i]), (LAS unsigned*)(lds + (bufoff) + ldsw + _i * 8192), 16, 0, MK_AUX_A); } while (0)
#define PG8_STAGE_B(bufoff, gbase) do { _Pragma("unroll") for (int _i = 0; _i < 2; ++_i) \
        __builtin_amdgcn_global_load_lds((const unsigned*)((const char*)(gbase) + voffB[_i]), (LAS unsigned*)(lds + (bufoff) + ldsw + _i * 8192), 16, 0, MK_AUX_B); } while (0)
#define PG8_LD8(p0) __builtin_shufflevector(*(const LAS v4i_t*)(p0), *(const LAS v4i_t*)((p0) + 1024), 0, 1, 2, 3, 4, 5, 6, 7)
#define PG8_LDA(dst, b, h) do { _Pragma("unroll") for (int m = 0; m < 4; ++m) dst[m] = PG8_LD8(lds + PG8_SA(b, h) + aoff + m * 2048); } while (0)
#define PG8_LDB(dst, b, h) do { _Pragma("unroll") for (int n = 0; n < 2; ++n) dst[n] = PG8_LD8(lds + PG8_SB(b, h) + boff + n * 2048); } while (0)
#define PG8_LO(v) __builtin_bit_cast(bf16x8, __builtin_shufflevector(v, v, 0, 1, 2, 3))
#define PG8_HI(v) __builtin_bit_cast(bf16x8, __builtin_shufflevector(v, v, 4, 5, 6, 7))
#define PG8_MMA(ai, bj, At, Bt) do { __builtin_amdgcn_s_setprio(1); _Pragma("unroll") for (int m = 0; m < 4; ++m) _Pragma("unroll") for (int n = 0; n < 2; ++n) { \
        if constexpr (P::FP8) asm volatile("v_mfma_scale_f32_16x16x128_f8f6f4 %0, %1, %2, %0, %3, %3 op_sel_hi:[0,0,0]" : "+v"(acc[ai][bj][m][n]) : "v"(Bt[n]), "v"(At[m]), "v"(sc127)); \
        else { acc[ai][bj][m][n] = __builtin_amdgcn_mfma_f32_16x16x32_bf16(PG8_LO(Bt[n]), PG8_LO(At[m]), acc[ai][bj][m][n], 0, 0, 0); \
               acc[ai][bj][m][n] = __builtin_amdgcn_mfma_f32_16x16x32_bf16(PG8_HI(Bt[n]), PG8_HI(At[m]), acc[ai][bj][m][n], 0, 0, 0); } } \
        __builtin_amdgcn_s_setprio(0); } while (0)
#define PG8_WAIT_V(n) asm volatile("s_waitcnt vmcnt(" #n ")" ::: "memory")
#define PG8_WAIT_VF(fresh_) do { if (fresh_) asm volatile("s_waitcnt vmcnt(%0)" :: "i"(8 + P::EPI_VM) : "memory"); else asm volatile("s_waitcnt vmcnt(8)" ::: "memory"); } while (0)
#define PG8_WAIT_L(n) asm volatile("s_waitcnt lgkmcnt(" #n ")" ::: "memory")
#define PG8_BAR __builtin_amdgcn_s_barrier()
#define PG8_SCHED __builtin_amdgcn_sched_barrier(0)
#define PG8_OFFS(u, O) do { _Pragma("unroll") for (int _h = 0; _h < 2; ++_h) _Pragma("unroll") for (int _i = 0; _i < 2; ++_i) \
        O[_h][_i] = P::GATHER ? (p.a_row(u, _h * HALF + RA[_i]) + CA2[_i]) : voffA[_i]; } while (0)
    Unit cur, nxt; int ui = 0;
    if (!p.next(0, cur)) return;
    Acc acc;
#pragma unroll
    for (int a = 0; a < 2; ++a)
#pragma unroll
        for (int b = 0; b < 2; ++b)
#pragma unroll
            for (int m = 0; m < 4; ++m)
#pragma unroll
                for (int n = 0; n < 2; ++n) acc[a][b][m][n] = (f32x4){0.f, 0.f, 0.f, 0.f};
    v8i_t At[4], B0[2], B1[2];
    const int sc127 = 127;
    const char* cA = p.a_base(cur); const char* cB = p.b_base(cur);
    unsigned cO[2][2], nO[2][2];
    PG8_OFFS(cur, cO);
    PG8_STAGE_B(PG8_SB(0, 0), cB); PG8_STAGE_B(PG8_SB(0, 1), cB + hB); PG8_STAGE_A(PG8_SA(0, 0), cA, cO[0]); PG8_STAGE_A(PG8_SA(0, 1), cA + hA, cO[1]);
    if (wr == 1) PG8_BAR;
    PG8_WAIT_V(2); PG8_BAR;
    PG8_STAGE_B(PG8_SB(1, 0), cB + kstep); PG8_STAGE_A(PG8_SA(1, 0), cA + kstep, cO[0]); PG8_STAGE_B(PG8_SB(1, 1), cB + hB + kstep);
    PG8_WAIT_V(6); PG8_BAR;
    for (;;) {
        const bool has_next = p.next(ui + 1, nxt);
        const char* nA = has_next ? p.a_base(nxt) : cA; const char* nB = has_next ? p.b_base(nxt) : cB;
        if (P::GATHER) { if (has_next) { PG8_OFFS(nxt, nO); } else {
#pragma unroll
            for (int h = 0; h < 2; ++h)
#pragma unroll
                for (int i = 0; i < 2; ++i) nO[h][i] = cO[h][i]; } }
#pragma nounroll
        for (int t = 0; t < nt; t += 2) {
            if constexpr (P::HOOK) { if (p.is_hook(t)) p.hook(acc, cur, t, wr, wc, fr, fq); }
            const bool last = (t == nt - 2);
            if constexpr (P::PRE) { if (last) p.pre(cur, wr, fr); }
            const char* a1 = cA + (size_t)(t + 1) * kstep;
            const char* a2 = last ? nA : cA + (size_t)(t + 2) * kstep; const char* b2 = last ? nB : cB + (size_t)(t + 2) * kstep;
            const char* a3 = a2 + kstep; const char* b3 = b2 + kstep;
            PG8_LDB(B0, 0, 0); PG8_LDB(B1, 0, 1); PG8_SCHED; PG8_LDA(At, 0, 0); PG8_STAGE_A(PG8_SA(1, 1), a1 + hA, cO[1]);
            PG8_WAIT_V(8); PG8_WAIT_L(0); PG8_BAR; PG8_MMA(0, 0, At, B0); PG8_MMA(0, 1, At, B1); PG8_BAR; PG8_SCHED;
            if (P::GATHER && last) {
#pragma unroll
                for (int h = 0; h < 2; ++h)
#pragma unroll
                    for (int i = 0; i < 2; ++i) cO[h][i] = nO[h][i]; }
            PG8_LDA(At, 0, 1); PG8_STAGE_B(PG8_SB(0, 0), b2); PG8_STAGE_B(PG8_SB(0, 1), b2 + hB); PG8_STAGE_A(PG8_SA(0, 0), a2, cO[0]);
            PG8_WAIT_V(8); PG8_WAIT_L(0); PG8_BAR; PG8_MMA(1, 0, At, B0); PG8_MMA(1, 1, At, B1); PG8_BAR; PG8_SCHED;
            PG8_LDB(B0, 1, 0); PG8_LDB(B1, 1, 1); PG8_SCHED; PG8_LDA(At, 1, 0); PG8_STAGE_A(PG8_SA(0, 1), a2 + hA, cO[1]);
            PG8_WAIT_V(8); PG8_WAIT_L(0); PG8_BAR; PG8_MMA(0, 0, At, B0); PG8_MMA(0, 1, At, B1); PG8_BAR; PG8_SCHED;
            PG8_LDA(At, 1, 1); PG8_STAGE_B(PG8_SB(1, 0), b3); PG8_STAGE_B(PG8_SB(1, 1), b3 + hB); PG8_STAGE_A(PG8_SA(1, 0), a3, cO[0]);
            PG8_WAIT_V(8); PG8_WAIT_L(0); PG8_BAR; PG8_MMA(1, 0, At, B0); PG8_MMA(1, 1, At, B1); PG8_BAR; PG8_SCHED;
        }
        if constexpr (ALIGN_EPI) { if (wr == 0) PG8_BAR; }
        if constexpr (P::FP8) asm volatile("s_nop 15\n\ts_nop 7" ::: "memory");
        p.epi(acc, cur, wr, wc, fr, fq);
        if (!has_next) break;
#pragma unroll
        for (int a = 0; a < 2; ++a)
#pragma unroll
            for (int b = 0; b < 2; ++b)
#pragma unroll
                for (int m = 0; m < 4; ++m)
#pragma unroll
                    for (int n = 0; n < 2; ++n) acc[a][b][m][n] = (f32x4){0.f, 0.f, 0.f, 0.f};
        cur = nxt; cA = nA; cB = nB; ++ui;
        if constexpr (ALIGN_EPI) { if (wr == 1) PG8_BAR; }
    }
    PG8_WAIT_V(0);
    if constexpr (!ALIGN_EPI) { if (wr == 0) PG8_BAR; }
    PG8_BAR;
#undef PG8_SA
#undef PG8_SB
#undef PG8_STAGE_A
#undef PG8_STAGE_B
#undef PG8_LDA
#undef PG8_LDB
#undef PG8_LD8
#undef PG8_LO
#undef PG8_HI
#undef PG8_MMA
#undef PG8_WAIT_V
#undef PG8_WAIT_VF
#undef PG8_WAIT_L
#undef PG8_BAR
#undef PG8_SCHED
#undef PG8_OFFS
}
}
namespace pol {
using pg8::Unit; using pg8::Acc; using pg8::Order;
#define EPI_ROWS(u) const int row0 = (u).pm * 256 + wr * 64 + fr; const int cl = wc * 32 + 8 * fq;
#define FOR_AI_M _Pragma("unroll") for (int ai = 0; ai < 2; ++ai) _Pragma("unroll") for (int m = 0; m < 4; ++m)

template <bool OUT8> struct PolPlainT : Order {
    static constexpr bool HOOK = false, GATHER = false, FP8 = false, PRE = false; static constexpr int EPI_VM = 16;
    const char* A; const char* Bt; char* C; int lda_, ldb_, ldc_, nt_;
    int mper, n0, n1; size_t a0, a1, a2, b0, b1, b2, c0, c1, c2;
    __device__ __forceinline__ int nt() const { return nt_; }
    __device__ __forceinline__ int lda() const { return lda_; }
    __device__ __forceinline__ int ldb() const { return ldb_; }
    __device__ __forceinline__ void dec(const Unit& u, int& j0, int& j1, int& j2, int& r) const { const int j = u.pm / mper; r = u.pm % mper; j0 = j % n0; j1 = (j / n0) % n1; j2 = j / (n0 * n1); }
    __device__ __forceinline__ const char* a_base(const Unit& u) const { int j0, j1, j2, r; dec(u, j0, j1, j2, r); return A + j0 * a0 + j1 * a1 + j2 * a2 + (size_t)r * 256 * lda_; }
    __device__ __forceinline__ const char* b_base(const Unit& u) const { int j0, j1, j2, r; dec(u, j0, j1, j2, r); return Bt + j0 * b0 + j1 * b1 + j2 * b2 + (size_t)u.pn * 256 * ldb_; }
    __device__ __forceinline__ unsigned a_row(const Unit&, int) const { return 0u; }
    __device__ __forceinline__ bool is_hook(int) const { return false; }
    __device__ __forceinline__ void hook(Acc&, const Unit&, int, int, int, int, int) const {}
    __device__ __forceinline__ void epi(const Acc& acc, const Unit& u, int wr, int wc, int fr, int fq) const {
        int j0, j1, j2, r; dec(u, j0, j1, j2, r); const int cl = wc * 32 + 8 * fq; constexpr int EB = OUT8 ? 1 : 2;
        char* cb = C + j0 * c0 + j1 * c1 + j2 * c2 + (size_t)(r * 256 + wr * 64 + fr) * ldc_ + (size_t)(u.pn * 256 + cl) * EB;
        FOR_AI_M { char* rp = cb + (size_t)(ai * 128 + m * 16) * ldc_;
#pragma unroll
            for (int bj = 0; bj < 2; ++bj) { if constexpr (OUT8) *(u32x2*)(rp + bj * 128) = pack8_fp8(acc[ai][bj][m][0] * W8_SCALE, acc[ai][bj][m][1] * W8_SCALE); else *(u32x4*)(rp + bj * 256) = pack8(acc[ai][bj][m][0], acc[ai][bj][m][1]); } }
    }
};
typedef PolPlainT<false> PolPlain;
typedef PolPlainT<true> PolPlain8;

template <bool F8> struct PolZT : Order {
    static constexpr bool HOOK = false, GATHER = false, FP8 = F8, PRE = false; static constexpr int EPI_VM = 8;
    const char* A; const char* Bt; const u64* ss; LAS bf16* bzl; unsigned char* R1; LAS float* rsl; mutable int cpm;
    __device__ __forceinline__ int nt() const { return F8 ? D / 128 : D / 64; }
    __device__ __forceinline__ int lda() const { return F8 ? D : 2 * D; }
    __device__ __forceinline__ int ldb() const { return F8 ? D : 2 * D; }
    __device__ __forceinline__ const char* a_base(const Unit& u) const { return A + (size_t)u.pm * 256 * lda(); }
    __device__ __forceinline__ const char* b_base(const Unit& u) const { return Bt + (size_t)u.pn * 256 * ldb(); }
    __device__ __forceinline__ unsigned a_row(const Unit&, int) const { return 0u; }
    mutable float pr[2][4];
    __device__ __forceinline__ void pre(const Unit& u, int wr, int fr) const { const int row0 = u.pm * 256 + wr * 64 + fr; FOR_AI_M pr[ai][m] = (float)ss[row0 + ai * 128 + m * 16]; }
    __device__ __forceinline__ bool is_hook(int) const { return false; }
    __device__ __forceinline__ void hook(Acc&, const Unit&, int, int, int, int, int) const {}
    __device__ __forceinline__ void epi(const Acc& acc, const Unit& u, int wr, int wc, int fr, int fq) const {
        EPI_ROWS(u); const int pn = u.pn;
        unsigned char* r1 = R1; asm volatile("" : "+s"(r1));
        f32x4 bv[2][2];
#pragma unroll
        for (int bj = 0; bj < 2; ++bj) { const u32x4 bw = *(const LAS u32x4*)(bzl + pn * 256 + bj * 128 + cl); unpack8(bw, bv[bj][0], bv[bj][1]); }
        if (u.pm != cpm) {
            const int tl = (wr * 4 + wc) * 64 + fq * 16 + fr; if (tl < 256) rsl[tl] = row_rstd(ss, u.pm * 256 + tl);
            asm volatile("s_waitcnt lgkmcnt(0)" ::: "memory"); __builtin_amdgcn_s_barrier(); asm volatile("" ::: "memory"); cpm = u.pm; }
        float rs8[2][4];
        FOR_AI_M rs8[ai][m] = rsl[ai * 128 + wr * 64 + m * 16 + fr] * (F8 ? W8_INV : 1.f);
#define Z_(bj, n) (acc[ai][bj][m][n] * rs8[ai][m] + bv[bj][n])
        constexpr int NV = (!F8 || MK_Z_ALL_FP8) ? 10 : 0;
        bf16 *AG = (bf16*)(r1 + R_AG), *GB = (bf16*)(r1 + R_GB), *CP = (bf16*)(r1 + R_CP);
        if (pn < NV) {
            if (pn < 4) {
                FOR_AI_M { const int row = row0 + ai * 128 + m * 16; f32x4 o[2];
#pragma unroll
                    for (int n = 0; n < 2; ++n) { const f32x4 zv = Z_(0, n), zg = Z_(1, n);
#pragma unroll
                        for (int j = 0; j < 4; ++j) o[n][j] = zv[j] * sigmoidf_(zg[j]); }
                    VAL_ST(u32x4, (char*)AG + ((unsigned)row * CA + pn * 128 + cl) * 2u, pack8(o[0], o[1])); }
            } else if (pn < 6) {
                FOR_AI_M { const int row = row0 + ai * 128 + m * 16;
#pragma unroll
                    for (int bj = 0; bj < 2; ++bj) VAL_ST(u32x4, (char*)GB + ((unsigned)row * CS + (pn - 4) * 256 + bj * 128 + cl) * 2u, pack8(Z_(bj, 0), Z_(bj, 1))); }
            } else {
                FOR_AI_M { const int row = row0 + ai * 128 + m * 16;
                    VAL_ST(u32x4, (char*)CP + ((unsigned)row * CS + (pn - 6) * 128 + cl) * 2u, pack8(Z_(0, 0) * Z_(1, 0), Z_(0, 1) * Z_(1, 1))); }
            }
        } else if constexpr (F8) {
            const int pq = pn - NV;
            bf16 *Q = (bf16*)(r1 + R_Q), *K = (bf16*)(r1 + R_K), *V = (bf16*)(r1 + R_V); unsigned char* Gt = r1 + R_G;
            if (pq < 9) {
                const int which = pq / 3, g = pq % 3; bf16* base = which == 0 ? Q : (which == 1 ? K : V); const float sc = which == 0 ? C2 : 1.f;
                FOR_AI_M { const int row = row0 + ai * 128 + m * 16;
#pragma unroll
                    for (int bj = 0; bj < 2; ++bj) QKV_ST(u32x4, (char*)base + ((unsigned)row * DW + g * 256 + bj * 128 + cl) * 2u, pack8(Z_(bj, 0) * sc, Z_(bj, 1) * sc)); }
            } else {
                FOR_AI_M {
#pragma unroll
                    for (int bj = 0; bj < 2; ++bj) { f32x4 o[2];
#pragma unroll
                        for (int n = 0; n < 2; ++n) { const f32x4 zz = Z_(bj, n);
#pragma unroll
                            for (int j = 0; j < 4; ++j) o[n][j] = sigmoidf_(zz[j]); }
                        GATE_ST(u32x2, Gt + gate_off(u.pm, (pq - 9) >> 2, (pq - 9) & 3, wr * 4 + wc, ai, m, bj, fq * 16 + fr), pack8_gate(o[0], o[1])); } }
            }
        }
#undef Z_
    }
};
typedef PolZT<false> PolZB;
typedef PolZT<true> PolZ8;

struct PolMerge : Order {
    static constexpr bool HOOK = true, GATHER = false, FP8 = false, PRE = false; static constexpr int EPI_VM = 16;
    const char* A; const char* Bt; const unsigned char* Gt; bf16* MRG;
    __device__ __forceinline__ int nt() const { return KCAT / 64; }
    __device__ __forceinline__ int lda() const { return KCAT * 2; }
    __device__ __forceinline__ int ldb() const { return KCAT * 2; }
    __device__ __forceinline__ const char* a_base(const Unit& u) const { return A + (size_t)u.pm * 256 * KCAT * 2; }
    __device__ __forceinline__ const char* b_base(const Unit& u) const { return Bt + (size_t)u.pn * 256 * KCAT * 2; }
    __device__ __forceinline__ unsigned a_row(const Unit&, int) const { return 0u; }
    __device__ __forceinline__ bool is_hook(int t) const { return t == 8 || t == 12; }
    __device__ __forceinline__ void hook(Acc& acc, const Unit& u, int t, int wr, int wc, int fr, int fq) const {
        const int br = (t == 8) ? 0 : 1;
        int lq = fq * 16 + fr; asm volatile("" : "+v"(lq));
        u32x2 wa[2][4][2], wb[2][4][2];
        FOR_AI_M {
#pragma unroll
            for (int bj = 0; bj < 2; ++bj) { wa[ai][m][bj] = GATE_LD((const u32x2*)(Gt + gate_off(u.pm, br, u.pn, wr * 4 + wc, ai, m, bj, lq))); wb[ai][m][bj] = GATE_LD((const u32x2*)(Gt + gate_off(u.pm, br + 1, u.pn, wr * 4 + wc, ai, m, bj, lq))); } }
        FOR_AI_M {
#pragma unroll
            for (int bj = 0; bj < 2; ++bj) { f32x4 a0, a1, b0, b1; unpack8_gate(wa[ai][m][bj], a0, a1); unpack8_gate(wb[ai][m][bj], b0, b1);
#pragma unroll
                for (int j = 0; j < 4; ++j) { acc[ai][bj][m][0][j] *= a0[j] * frcp(b0[j]); acc[ai][bj][m][1][j] *= a1[j] * frcp(b1[j]); } } }
    }
    __device__ __forceinline__ void epi(const Acc& acc, const Unit& u, int wr, int wc, int fr, int fq) const {
        EPI_ROWS(u);
        u32x2 gw[2][4][2];
        FOR_AI_M { gw[ai][m][0] = GATE_LD((const u32x2*)(Gt + gate_off(u.pm, 2, u.pn, wr * 4 + wc, ai, m, 0, fq * 16 + fr))); gw[ai][m][1] = GATE_LD((const u32x2*)(Gt + gate_off(u.pm, 2, u.pn, wr * 4 + wc, ai, m, 1, fq * 16 + fr))); }
        FOR_AI_M { const int row = row0 + ai * 128 + m * 16;
#pragma unroll
            for (int bj = 0; bj < 2; ++bj) { f32x4 a0, a1; unpack8_gate(gw[ai][m][bj], a0, a1);
                PL_ST(u32x4, (char*)MRG + ((unsigned)row * (unsigned)D + u.pn * 256 + bj * 128 + cl) * 2u, pack8(acc[ai][bj][m][0] * a0 * (1.f / 255.f), acc[ai][bj][m][1] * a1 * (1.f / 255.f))); } }
    }
};

template <bool F8> struct PolResT : Order {
    static constexpr bool HOOK = false, GATHER = false, FP8 = F8, PRE = false; static constexpr int EPI_VM = 16;
    const char* A; const char* Bt; size_t b_batch; int K; bf16* XB; u64* ssn; unsigned char* X8; float ascale;
    __device__ __forceinline__ int nt() const { return F8 ? K / 128 : K / 64; }
    __device__ __forceinline__ int lda() const { return F8 ? K : K * 2; }
    __device__ __forceinline__ int ldb() const { return F8 ? K : K * 2; }
    __device__ __forceinline__ const char* a_base(const Unit& u) const { return A + (size_t)u.pm * 256 * lda(); }
    __device__ __forceinline__ const char* b_base(const Unit& u) const { return Bt + (u.pm >= 64 ? b_batch : (size_t)0) + (size_t)u.pn * 256 * ldb(); }
    __device__ __forceinline__ unsigned a_row(const Unit&, int) const { return 0u; }
    __device__ __forceinline__ bool is_hook(int) const { return false; }
    __device__ __forceinline__ void hook(Acc&, const Unit&, int, int, int, int, int) const {}
    __device__ __forceinline__ void epi(const Acc& acc, const Unit& u, int wr, int wc, int fr, int fq) const {
        EPI_ROWS(u); const float as = ascale;
        const char* xbc = (const char*)XB; char* xbw = (char*)XB;
        u32x4 old[2][4][2];
        FOR_AI_M { const unsigned ob = ((unsigned)(row0 + ai * 128 + m * 16) * (unsigned)D + (unsigned)(u.pn * 256 + cl)) * 2u; old[ai][m][0] = RES_LD((const u32x4*)(xbc + ob)); old[ai][m][1] = RES_LD((const u32x4*)(xbc + ob + 256u)); }
        FOR_AI_M { const unsigned row = (unsigned)(row0 + ai * 128 + m * 16); const unsigned oe = row * (unsigned)D + (unsigned)(u.pn * 256 + cl); float sq = 0.f;
#pragma unroll
            for (int bj = 0; bj < 2; ++bj) { f32x4 v0, v1;
                unpack8(old[ai][m][bj], v0, v1);
                v0 = v0 + acc[ai][bj][m][0] * as; v1 = v1 + acc[ai][bj][m][1] * as;
                sq += (v0[0] * v0[0] + v0[1] * v0[1]) + (v0[2] * v0[2] + v0[3] * v0[3]) + (v1[0] * v1[0] + v1[1] * v1[1]) + (v1[2] * v1[2] + v1[3] * v1[3]);
                *(u32x4*)(xbw + (oe + bj * 128u) * 2u) = pack8(v0, v1);
                if (X8) *(u32x2*)(X8 + (oe + bj * 128u)) = pack8_fp8(v0, v1); }
            sq += __shfl_xor(sq, 16); sq += __shfl_xor(sq, 32);
            if (fq == 0) row_ss_add(ssn, (int)row, sq); }
    }
};
typedef PolResT<false> PolRes;
typedef PolResT<true> PolRes8;

struct PolXS : Order {
    static constexpr bool HOOK = false, GATHER = false, FP8 = true, PRE = false; static constexpr int EPI_VM = 16;
    const char* A; const char* Bt; size_t b_batch; const u64* ss; unsigned char* P; LAS float* xch;
    mutable int parity;
    __device__ __forceinline__ int nt() const { return D / 128; }
    __device__ __forceinline__ int lda() const { return D; }
    __device__ __forceinline__ int ldb() const { return D; }
    __device__ __forceinline__ const char* a_base(const Unit& u) const { return A + (size_t)u.pm * 256 * D; }
    __device__ __forceinline__ const char* b_base(const Unit& u) const { return Bt + (u.pm >= 64 ? b_batch : (size_t)0) + (size_t)u.pn * 256 * D; }
    __device__ __forceinline__ unsigned a_row(const Unit&, int) const { return 0u; }
    mutable float pr[2][4];
    __device__ __forceinline__ void pre(const Unit& u, int wr, int fr) const { const int row0 = u.pm * 256 + wr * 64 + fr; FOR_AI_M pr[ai][m] = (float)ss[row0 + ai * 128 + m * 16]; }
    __device__ __forceinline__ bool is_hook(int) const { return false; }
    __device__ __forceinline__ void hook(Acc&, const Unit&, int, int, int, int, int) const {}
    __device__ __forceinline__ void epi(const Acc& acc, const Unit& u, int wr, int wc, int fr, int fq) const {
        EPI_ROWS(u);
        LAS float* xb = xch + parity * 2048; parity ^= 1;
        Acc& pa = const_cast<Acc&>(acc);
        float rs8[2][4], mloc[2][4];
        FOR_AI_M rs8[ai][m] = row_rstd(ss, row0 + ai * 128 + m * 16) * W8_INV;
        FOR_AI_M { const float rs = rs8[ai][m];
            float mx = -3.0e38f;
#pragma unroll
            for (int bj = 0; bj < 2; ++bj)
#pragma unroll
                for (int n = 0; n < 2; ++n)
#pragma unroll
                    for (int j = 0; j < 4; ++j) mx = fmaxf(mx, acc[ai][bj][m][n][j] * rs);
            mx = fmaxf(mx, __shfl_xor(mx, 16)); mx = fmaxf(mx, __shfl_xor(mx, 32));
            float sm = 0.f;
#pragma unroll
            for (int bj = 0; bj < 2; ++bj)
#pragma unroll
                for (int n = 0; n < 2; ++n)
#pragma unroll
                    for (int j = 0; j < 4; ++j) { const float pv = fexp2(acc[ai][bj][m][n][j] * rs - mx); pa[ai][bj][m][n][j] = pv; sm += pv; }
            sm += __shfl_xor(sm, 16); sm += __shfl_xor(sm, 32); mloc[ai][m] = mx;
            if (fq == 0) { const int rl = ai * 128 + wr * 64 + m * 16 + fr; *(LAS f32x2*)(xb + (rl * 4 + wc) * 2) = (f32x2){mx, sm}; } }
        asm volatile("s_waitcnt lgkmcnt(0)" ::: "memory"); __builtin_amdgcn_s_barrier(); asm volatile("" ::: "memory");
        FOR_AI_M { const int row = row0 + ai * 128 + m * 16;
            const int rl = ai * 128 + wr * 64 + m * 16 + fr;
            const f32x4 e0 = *(const LAS f32x4*)(xb + rl * 8), e1 = *(const LAS f32x4*)(xb + rl * 8 + 4);
            const float MX = fmaxf(fmaxf(e0[0], e0[2]), fmaxf(e1[0], e1[2]));
            const float L = e0[1] * fexp2(e0[0] - MX) + e0[3] * fexp2(e0[2] - MX) + e1[1] * fexp2(e1[0] - MX) + e1[3] * fexp2(e1[2] - MX);
            const float inv = frcp(L) * W8_SCALE * fexp2(mloc[ai][m] - MX);
#pragma unroll
            for (int bj = 0; bj < 2; ++bj) { f32x4 o[2];
#pragma unroll
                for (int n = 0; n < 2; ++n)
#pragma unroll
                    for (int j = 0; j < 4; ++j) o[n][j] = pa[ai][bj][m][n][j] * inv;
                PL_ST(u32x2, P + ((unsigned)row * (unsigned)D + u.pn * 256 + bj * 128 + cl), pack8_fp8(o[0], o[1])); } }
    }
};

struct PolUp : Order {
    static constexpr bool HOOK = false, GATHER = false, FP8 = true, PRE = false; static constexpr int EPI_VM = 8;
    const char* A; const char* Bt; const u64* ss; unsigned char* U; int out16; LAS float* rsl; mutable int cpm;
    __device__ __forceinline__ int nt() const { return D / 128; }
    __device__ __forceinline__ int lda() const { return D; }
    __device__ __forceinline__ int ldb() const { return D; }
    __device__ __forceinline__ const char* a_base(const Unit& u) const { return A + (size_t)u.pm * 256 * D; }
    __device__ __forceinline__ const char* b_base(const Unit& u) const { return Bt + (size_t)u.pn * 256 * D; }
    __device__ __forceinline__ unsigned a_row(const Unit&, int) const { return 0u; }
    mutable float pr[2][4];
    __device__ __forceinline__ void pre(const Unit& u, int wr, int fr) const { const int row0 = u.pm * 256 + wr * 64 + fr; FOR_AI_M pr[ai][m] = (float)ss[row0 + ai * 128 + m * 16]; }
    __device__ __forceinline__ bool is_hook(int) const { return false; }
    __device__ __forceinline__ void hook(Acc&, const Unit&, int, int, int, int, int) const {}
    __device__ __forceinline__ void epi(const Acc& acc, const Unit& u, int wr, int wc, int fr, int fq) const {
        EPI_ROWS(u);
        if (u.pm != cpm) { const int tl = (wr * 4 + wc) * 64 + fq * 16 + fr; if (tl < 256) rsl[tl] = row_rstd(ss, u.pm * 256 + tl);
            asm volatile("s_waitcnt lgkmcnt(0)" ::: "memory"); __builtin_amdgcn_s_barrier(); asm volatile("" ::: "memory"); cpm = u.pm; }
        float rs8[2][4];
        FOR_AI_M rs8[ai][m] = rsl[ai * 128 + wr * 64 + m * 16 + fr] * W8_INV;
        FOR_AI_M { const int row = row0 + ai * 128 + m * 16; const float rs = rs8[ai][m]; const float cs = -LOG2E * rs, s2 = rs * rs;
            f32x4 o[2];
#pragma unroll
            for (int n = 0; n < 2; ++n)
#pragma unroll
                for (int j = 0; j < 4; ++j) { const float a = acc[ai][0][m][n][j], b = acc[ai][1][m][n][j]; o[n][j] = (a * b) * frcp(1.f + fexp2(cs * a)) * s2; }
            if (out16) PL_ST(u32x4, U + ((unsigned)row * (unsigned)DFF + u.pn * 128 + cl) * 2u, pack8(o[0], o[1])); else PL_ST(u32x2, U + ((unsigned)row * (unsigned)DFF + u.pn * 128 + cl), pack8_fp8(o[0], o[1])); }
    }
};

struct PolUpB : Order {
    static constexpr bool HOOK = false, GATHER = false, FP8 = false, PRE = false; static constexpr int EPI_VM = 8;
    const char* A; const char* Bt; const u64* ss; unsigned char* U; int out16; LAS float* rsl; mutable int cpm;
    __device__ __forceinline__ int nt() const { return 16; }
    __device__ __forceinline__ int lda() const { return 2048; }
    __device__ __forceinline__ int ldb() const { return 2048; }
    __device__ __forceinline__ const char* a_base(const Unit& u) const { return A + (size_t)u.pm * 256 * 2048; }
    __device__ __forceinline__ const char* b_base(const Unit& u) const { return Bt + (size_t)u.pn * 256 * 2048; }
    __device__ __forceinline__ unsigned a_row(const Unit&, int) const { return 0u; }
    mutable float pr[2][4];
    __device__ __forceinline__ void pre(const Unit& u, int wr, int fr) const { const int row0 = u.pm * 256 + wr * 64 + fr; FOR_AI_M pr[ai][m] = (float)ss[row0 + ai * 128 + m * 16]; }
    __device__ __forceinline__ bool is_hook(int) const { return false; }
    __device__ __forceinline__ void hook(Acc&, const Unit&, int, int, int, int, int) const {}
    __device__ __forceinline__ void epi(const Acc& acc, const Unit& u, int wr, int wc, int fr, int fq) const {
        EPI_ROWS(u);
        if (u.pm != cpm) { const int tl = (wr * 4 + wc) * 64 + fq * 16 + fr; if (tl < 256) rsl[tl] = row_rstd(ss, u.pm * 256 + tl);
            asm volatile("s_waitcnt lgkmcnt(0)" ::: "memory"); __builtin_amdgcn_s_barrier(); asm volatile("" ::: "memory"); cpm = u.pm; }
        float rs8[2][4];
        FOR_AI_M rs8[ai][m] = rsl[ai * 128 + wr * 64 + m * 16 + fr];
        FOR_AI_M { const int row = row0 + ai * 128 + m * 16; const float rs = rs8[ai][m]; const float cs = -LOG2E * rs, s2 = rs * rs;
            f32x4 o[2];
#pragma unroll
            for (int n = 0; n < 2; ++n)
#pragma unroll
                for (int j = 0; j < 4; ++j) { const float a = acc[ai][0][m][n][j], b = acc[ai][1][m][n][j]; o[n][j] = (a * b) * frcp(1.f + fexp2(cs * a)) * s2; }
            if (out16) PL_ST(u32x4, U + ((unsigned)row * (unsigned)DFF + u.pn * 128 + cl) * 2u, pack8(o[0], o[1])); else PL_ST(u32x2, U + ((unsigned)row * (unsigned)DFF + u.pn * 128 + cl), pack8_fp8(o[0], o[1])); }
    }
};

struct MoeTiles {
    int tb[2][9];
    __device__ __forceinline__ void init(const unsigned* cnt  ) {
#pragma unroll
        for (int p = 0; p < 2; ++p) { int s = 0;
#pragma unroll
            for (int e = 0; e < 8; ++e) { tb[p][e] = s; s += ((int)cnt[64 * (8 * p + e)] + 255) >> 8; }
            tb[p][8] = s; }
    }
    __device__ __forceinline__ int ntiles() const { return tb[0][8] + tb[1][8]; }
    __device__ __forceinline__ void decode(int pm, int& e, int& st) const {
        const int p = pm >= tb[0][8] ? 1 : 0, rt = pm - (p ? tb[0][8] : 0); e = 0;
#pragma unroll
        for (int k = 1; k < 8; ++k) e += (rt >= (p ? tb[1][k] : tb[0][k])) ? 1 : 0;
        st = p * MAXRT + rt; }
};

struct PolMoeUp : Order {
    static constexpr bool HOOK = false, GATHER = true, FP8 = true, PRE = false; static constexpr int EPI_VM = 8;
    const char* A; const char* Bt; const int* list; const float* lr; unsigned char* U; MoeTiles mt; mutable float pr[2][4];
    __device__ __forceinline__ int nt() const { return D / 128; }
    __device__ __forceinline__ int lda() const { return D; }
    __device__ __forceinline__ int ldb() const { return D; }
    __device__ __forceinline__ const char* a_base(const Unit&) const { return A; }
    __device__ __forceinline__ const char* b_base(const Unit& u) const { int e, st; mt.decode(u.pm, e, st); return Bt + (size_t)e * (2 * MFF) * D + (size_t)u.pn * 256 * D; }
    __device__ __forceinline__ unsigned a_row(const Unit& u, int r) const { int e, st; mt.decode(u.pm, e, st); int tok = list[st * 256 + r]; tok = tok < 0 ? 0 : tok; return (unsigned)tok * (unsigned)D; }
    __device__ __forceinline__ void pre(const Unit& u, int wr, int fr) const { int e, st; mt.decode(u.pm, e, st); const int row0 = st * 256 + wr * 64 + fr; FOR_AI_M pr[ai][m] = lr[row0 + ai * 128 + m * 16]; }
    __device__ __forceinline__ bool is_hook(int) const { return false; }
    __device__ __forceinline__ void hook(Acc&, const Unit&, int, int, int, int, int) const {}
    __device__ __forceinline__ void epi(const Acc& acc, const Unit& u, int wr, int wc, int fr, int fq) const {
        int e, st; mt.decode(u.pm, e, st); const int row0 = st * 256 + wr * 64 + fr; const int cl = wc * 32 + 8 * fq;
        FOR_AI_M { const int row = row0 + ai * 128 + m * 16; const float cs = -LOG2E * W8_INV, s2 = W8_INV * W8_INV;
            f32x4 o[2];
#pragma unroll
            for (int n = 0; n < 2; ++n)
#pragma unroll
                for (int j = 0; j < 4; ++j) { const float a = acc[ai][0][m][n][j], b = acc[ai][1][m][n][j]; o[n][j] = (a * b) * frcp(1.f + fexp2(cs * a)) * s2; }
            NT_ST(u32x2, U + ((unsigned)row * (unsigned)MFF + u.pn * 128 + cl), pack8_fp8(o[0], o[1])); }
    }
};
struct PolMoeDown : Order {
    static constexpr bool HOOK = false, GATHER = false, FP8 = true, PRE = false; static constexpr int EPI_VM = 16;
    const char* A; const char* Bt; const float* lw; bf16* Y; MoeTiles mt; mutable float pr[2][4]; int l_off, l_end;
    __device__ __forceinline__ bool next(int i, Unit& u) const { const long L = (long)l_off + (long)i * G + c; if (L >= l_end) return false; u.pm = (int)(L >> 2); u.pn = (int)(L & 3); return true; }
    __device__ __forceinline__ int nt() const { return MFF / 128; }
    __device__ __forceinline__ int lda() const { return MFF; }
    __device__ __forceinline__ int ldb() const { return MFF; }
    __device__ __forceinline__ const char* a_base(const Unit& u) const { int e, st; mt.decode(u.pm, e, st); return A + (size_t)st * 256 * MFF; }
    __device__ __forceinline__ const char* b_base(const Unit& u) const { int e, st; mt.decode(u.pm, e, st); return Bt + (size_t)e * D * MFF + (size_t)u.pn * 256 * MFF; }
    __device__ __forceinline__ unsigned a_row(const Unit&, int) const { return 0u; }
    __device__ __forceinline__ void pre(const Unit& u, int wr, int fr) const { int e, st; mt.decode(u.pm, e, st); const int row0 = st * 256 + wr * 64 + fr; FOR_AI_M pr[ai][m] = lw[row0 + ai * 128 + m * 16]; }
    __device__ __forceinline__ bool is_hook(int) const { return false; }
    __device__ __forceinline__ void hook(Acc&, const Unit&, int, int, int, int, int) const {}
    __device__ __forceinline__ void epi(const Acc& acc, const Unit& u, int wr, int wc, int fr, int fq) const {
        int e, st; mt.decode(u.pm, e, st); const int row0 = st * 256 + wr * 64 + fr; const int cl = wc * 32 + 8 * fq;
        FOR_AI_M { const int row = row0 + ai * 128 + m * 16; const float w = W8_INV;
#pragma unroll
            for (int bj = 0; bj < 2; ++bj) NT_ST(u32x4, (char*)Y + ((unsigned)row * (unsigned)D + u.pn * 256 + bj * 128 + cl) * 2u, pack8(acc[ai][bj][m][0] * w, acc[ai][bj][m][1] * w)); }
    }
};
}
struct Ctx {
    LAS unsigned char* lds; int tid, lane, wave, G, bid, gw, NGW;
};

__device__ __forceinline__ int zmapB(int n) {
    const int pn = n >> 8, c = n & 255, bj = c >> 7, cc = c & 127;
    if (pn < 4) return OFF_A + (bj ? 512 : 0) + pn * 128 + cc;
    if (pn < 6) return OFF_CB + (pn - 4) * 256 + c;
    return (bj ? OFF_CH : OFF_CC) + (pn - 6) * 128 + cc;
}
__device__ __forceinline__ int zmap8(int n) {
    if (MK_Z_ALL_FP8) { if (n < 10 * 256) return zmapB(n); n -= 10 * 256; }
    const int pn = n >> 8, c = n & 255;
    if (pn < 9) return OFF_Q + pn * 256 + c;
    return OFF_G + (pn - 9) * 256 + c;
}
constexpr int TR_SCR = 64 * 65 * 4;
template <int MAP, bool OUT8 = false>
__device__ __forceinline__ void tr_matrix(const Ctx& F, int& rot, const float* src, const float* src2, int K, int N, int ldsrc, bf16* dst, int lddst, int dstk0, const float* gain) {
    LAS float* scr = (LAS float*)(F.lds + F.wave * TR_SCR);
    const int nblk = N / 64, nitems = (K / 64) * nblk, lane = F.lane;
    const int first = (F.gw - rot + F.NGW) % F.NGW; rot = (rot + nitems) % F.NGW;
    f32x4 v[16];
#define TR_LOAD(it_) do { const int kb_ = (it_) / nblk, nb_ = (it_) % nblk, n0_ = 64 * nb_; const float* s_ = src; int sn0_ = n0_; \
        if (MAP == 1) sn0_ = zmapB(n0_); if (MAP == 3) sn0_ = zmap8(n0_); \
        if (MAP == 2) { const int pn_ = n0_ >> 8, c_ = n0_ & 255; s_ = (c_ >> 7) ? src2 : src; sn0_ = pn_ * 128 + (c_ & 127); } \
        _Pragma("unroll") for (int i = 0; i < 16; ++i) v[i] = NT_LD((const f32x4*)(s_ + (size_t)(64 * kb_ + 4 * i + (lane >> 4)) * ldsrc + sn0_ + 4 * (lane & 15))); } while (0)
    if (first < nitems) TR_LOAD(first);
    for (int it = first; it < nitems; it += F.NGW) {
        const int kb = it / nblk, nb = it % nblk, k0 = 64 * kb, n0 = 64 * nb;
#pragma unroll
        for (int i = 0; i < 16; ++i) { const int kk = 4 * i + (lane >> 4); f32x4 w = v[i]; if (gain) w = w * gain[k0 + kk];
            LAS float* q = scr + kk * 65 + 4 * (lane & 15); q[0] = w[0]; q[1] = w[1]; q[2] = w[2]; q[3] = w[3]; }
        LDS_WAIT(); asm volatile("" ::: "memory");
        if (it + F.NGW < nitems) TR_LOAD(it + F.NGW);
        const int c = lane & 7;
#pragma unroll
        for (int j = 0; j < 8; ++j) { const int n = (lane >> 3) + 8 * j; const LAS float* q = scr + (8 * c) * 65 + n;
            if constexpr (OUT8) { u32x2 o; o.x = pk4_fp8(clamp8(q[0 * 65] * W8_SCALE), clamp8(q[1 * 65] * W8_SCALE), clamp8(q[2 * 65] * W8_SCALE), clamp8(q[3 * 65] * W8_SCALE));
                o.y = pk4_fp8(clamp8(q[4 * 65] * W8_SCALE), clamp8(q[5 * 65] * W8_SCALE), clamp8(q[6 * 65] * W8_SCALE), clamp8(q[7 * 65] * W8_SCALE));
                *(u32x2*)((unsigned char*)dst + (size_t)(n0 + n) * lddst + dstk0 + k0 + 8 * c) = o; }
            else { u32x4 o; o.x = cvt_pk_bf16(q[0 * 65], q[1 * 65]); o.y = cvt_pk_bf16(q[2 * 65], q[3 * 65]); o.z = cvt_pk_bf16(q[4 * 65], q[5 * 65]); o.w = cvt_pk_bf16(q[6 * 65], q[7 * 65]);
                *(u32x4*)(dst + (size_t)(n0 + n) * lddst + dstk0 + k0 + 8 * c) = o; } }
        LDS_WAIT(); asm volatile("" ::: "memory");
    }
#undef TR_LOAD
}
__device__ __forceinline__ void cv_rows(const Ctx& F, const float* src, bf16* dst, int R, const float* rowgain, float scale) {
    for (int r = F.gw; r < R; r += F.NGW) { const float g = rowgain[r] * scale; const f32x4* s = (const f32x4*)(src + (size_t)r * D) + F.lane; unsigned long long* o = (unsigned long long*)(dst + (size_t)r * D) + F.lane;
#pragma unroll
        for (int j = 0; j < 4; ++j) { const f32x4 v = s[64 * j] * g; o[64 * j] = (unsigned long long)pk2(v[0], v[1]) | ((unsigned long long)pk2(v[2], v[3]) << 32); } }
}
__device__ __forceinline__ void rows_raw_ss(const Ctx& F, const float* x, bf16* xb, unsigned char* x8, u64* ss) {
    f32x4 v[4], nv[4];
    if (F.gw < M) { const f32x4* s = (const f32x4*)(x + (size_t)F.gw * D) + F.lane;
#pragma unroll
        for (int j = 0; j < 4; ++j) v[j] = NT_LD(s + 64 * j); }
    for (int r = F.gw; r < M; r += F.NGW) {
        if (r + F.NGW < M) { const f32x4* s = (const f32x4*)(x + (size_t)(r + F.NGW) * D) + F.lane;
#pragma unroll
            for (int j = 0; j < 4; ++j) nv[j] = NT_LD(s + 64 * j); }
        unsigned long long* o = (unsigned long long*)(xb + (size_t)r * D) + F.lane; unsigned* o8 = (unsigned*)(x8 + (size_t)r * D) + F.lane; float sq = 0.f;
#pragma unroll
        for (int j = 0; j < 4; ++j) { sq += (v[j][0] * v[j][0] + v[j][1] * v[j][1]) + (v[j][2] * v[j][2] + v[j][3] * v[j][3]);
            o[64 * j] = (unsigned long long)cvt_pk_bf16(v[j][0], v[j][1]) | ((unsigned long long)cvt_pk_bf16(v[j][2], v[j][3]) << 32); o8[64 * j] = pk4_fp8(clamp8(v[j][0]), clamp8(v[j][1]), clamp8(v[j][2]), clamp8(v[j][3])); }
        sq = wave_sum(sq); if (F.lane == 0) ss[r] = (u64)(sq * SS_SCALE);
#pragma unroll
        for (int j = 0; j < 4; ++j) v[j] = nv[j]; }
}
__device__ __forceinline__ void rows_rmsnorm_bf16(const Ctx& F, const float* x, const float* g, bf16* out, int R) {
    for (int r = F.gw; r < R; r += F.NGW) { const f32x4* s = (const f32x4*)(x + (size_t)r * D) + F.lane; const f32x4* gp = (const f32x4*)g + F.lane; unsigned long long* o = (unsigned long long*)(out + (size_t)r * D) + F.lane;
        f32x4 v[4]; float sq = 0.f;
#pragma unroll
        for (int j = 0; j < 4; ++j) { v[j] = s[64 * j]; sq += (v[j][0] * v[j][0] + v[j][1] * v[j][1]) + (v[j][2] * v[j][2] + v[j][3] * v[j][3]); }
        const float rs = __builtin_amdgcn_rsqf(wave_sum(sq) * (1.f / D) + EPS);
#pragma unroll
        for (int j = 0; j < 4; ++j) { const f32x4 w = v[j] * rs * gp[64 * j]; o[64 * j] = (unsigned long long)pk2(w[0], w[1]) | ((unsigned long long)pk2(w[2], w[3]) << 32); } }
}
__device__ __forceinline__ void rows_final(const Ctx& F, int gw, int NGW, const bf16* xb, const bf16* Y, const int* sl, const float* rw, const float* g, float* out, int nt0, int late_tile, int want_late) {
    u32x4 cx[2], c0[2], c1[2], nx[2], n0[2], n1[2]; f32x2 cw, nw; bool cok = false, nok = false;
#define RF_LOAD(r_, X_, A_, B_, W_, OK_) do { const int s0_ = sl[r_], s1_ = sl[M + (r_)]; const int t0_ = s0_ >> 8, t1_ = nt0 + ((s1_ - MOE_ROWS) >> 8); \
        OK_ = ((t0_ >= late_tile || t1_ >= late_tile) ? 1 : 0) == want_late; \
        if (OK_) { const u32x4* px_ = (const u32x4*)(xb + (size_t)(r_) * D) + F.lane; const u32x4* p0_ = (const u32x4*)(Y + (size_t)s0_ * D) + F.lane; \
        const u32x4* p1_ = (const u32x4*)(Y + (size_t)s1_ * D) + F.lane; X_[0] = px_[0]; X_[1] = px_[64]; A_[0] = p0_[0]; A_[1] = p0_[64]; B_[0] = p1_[0]; B_[1] = p1_[64]; W_ = *(const f32x2*)(rw + 2 * (r_)); } } while (0)
    f32x4 gv[4];
#pragma unroll
    for (int j = 0; j < 2; ++j) { gv[2 * j] = *(const f32x4*)(g + 512 * j + 8 * F.lane); gv[2 * j + 1] = *(const f32x4*)(g + 512 * j + 8 * F.lane + 4); }
    if (gw < M) RF_LOAD(gw, cx, c0, c1, cw, cok);
    for (int r = gw; r < M; r += NGW) {
        if (r + NGW < M) RF_LOAD(r + NGW, nx, n0, n1, nw, nok);
        if (cok) {
            f32x4 v[4]; float sq = 0.f;
#pragma unroll
            for (int j = 0; j < 2; ++j) { f32x4 a0, a1, b0, b1, e0, e1; unpack8(cx[j], a0, a1); unpack8(c0[j], b0, b1); unpack8(c1[j], e0, e1);
                v[2 * j] = a0 + b0 * cw.x + e0 * cw.y; v[2 * j + 1] = a1 + b1 * cw.x + e1 * cw.y;
                sq += (v[2 * j][0] * v[2 * j][0] + v[2 * j][1] * v[2 * j][1]) + (v[2 * j][2] * v[2 * j][2] + v[2 * j][3] * v[2 * j][3]) + (v[2 * j + 1][0] * v[2 * j + 1][0] + v[2 * j + 1][1] * v[2 * j + 1][1]) + (v[2 * j + 1][2] * v[2 * j + 1][2] + v[2 * j + 1][3] * v[2 * j + 1][3]); }
            const float rs = __builtin_amdgcn_rsqf(wave_sum(sq) * (1.f / D) + EPS);
#pragma unroll
            for (int j = 0; j < 2; ++j) { f32x4* o = (f32x4*)(out + (size_t)r * D + 512 * j + 8 * F.lane); NT_ST(f32x4, o, v[2 * j] * rs * gv[2 * j]); NT_ST(f32x4, o + 1, v[2 * j + 1] * rs * gv[2 * j + 1]); } }
#pragma unroll
        for (int j = 0; j < 2; ++j) { cx[j] = nx[j]; c0[j] = n0[j]; c1[j] = n1[j]; }
        cw = nw; cok = nok; nok = false; }
#undef RF_LOAD
}

constexpr int DA_KP = 144, DA_VOFF = 256 * DA_KP, DA_IMG = 2 * DA_VOFF;
struct DaUnit { int b, g, h, d, r, n, col0; };
__device__ __forceinline__ DaUnit da_decode(int u) { DaUnit q; const int blk = u & 127; q.h = (u >> 7) & 3; q.g = (u >> 9) % 3; q.b = u / 1536;
    q.d = q.g == 0 ? 1 : (q.g == 1 ? 4 : 16); const int npr = 128 / q.d; q.r = blk / npr; q.n = blk % npr; q.col0 = q.g * 256 + q.h * 64; return q; }
__device__ __forceinline__ void da_load(const DaUnit& q, int tid, const bf16* Kg, const bf16* Vg, u32x4 (&kv)[4], u32x4 (&vv)[4]) {
#pragma unroll
    for (int i = 0; i < 4; ++i) { const int c = tid + 512 * i, j = c >> 3, part = c & 7; const int lk = 128 * (q.n - 1) + j;
        kv[i] = (u32x4){0u, 0u, 0u, 0u}; vv[i] = (u32x4){0u, 0u, 0u, 0u};
        if (lk >= 0) { const size_t off = ((size_t)q.b * SEQ + (size_t)lk * q.d + q.r) * DW + q.col0 + part * 8; kv[i] = *(const u32x4*)(Kg + off); vv[i] = *(const u32x4*)(Vg + off); } }
}
__device__ __forceinline__ void dil_attn_phase(const Ctx& F, bf16* QO, const bf16* Kg, const bf16* Vg, float* LSE) {
    const int tid = F.tid, lane = F.lane, fr = lane & 15, fq = lane >> 4;
    int w = tid >> 6; asm volatile("" : "+v"(w));
    const float NINF = -__builtin_inff();
    const int NU = NB * 3 * 4 * 128;
    int par = 0;
    u32x4 kv[4], vv[4]; bf16x8 qn[2];
#define DA_QLOAD(q_) do { const size_t rq_ = (size_t)(q_).b * SEQ + (size_t)(128 * (q_).n + 16 * w + fr) * (q_).d + (q_).r; \
        _Pragma("unroll") for (int ks = 0; ks < 2; ++ks) qn[ks] = *(const bf16x8*)(QO + rq_ * DW + (q_).col0 + 32 * ks + 8 * fq); } while (0)
    const int vb = (F.G % 8 == 0) ? (F.bid % 8) * (F.G / 8) + F.bid / 8 : F.bid;
    if (vb < NU) { const DaUnit q0 = da_decode(vb); da_load(q0, tid, Kg, Vg, kv, vv); DA_QLOAD(q0); }
    for (int u = vb; u < NU; u += F.G) {
        const DaUnit q = da_decode(u);
        LAS unsigned char* lds = F.lds + par * DA_IMG; par ^= 1;
        const int d = q.d, r = q.r, n = q.n, col0 = q.col0;
        const size_t rb = (size_t)q.b * SEQ;
#pragma unroll
        for (int i = 0; i < 4; ++i) { const int c = tid + 512 * i, j = c >> 3, part = c & 7;
            *(LAS u32x4*)(lds + j * DA_KP + part * 16) = kv[i];
            *(LAS u32x4*)(lds + DA_VOFF + j * DA_KP + part * 16) = vv[i]; }
        const int qi = 16 * w + fr; const size_t rowq = rb + (size_t)(128 * n + qi) * d + r;
        bf16x8 qf[2]; qf[0] = qn[0]; qf[1] = qn[1];
        __syncthreads();
        if (u + F.G < NU) { const DaUnit qx = da_decode(u + F.G); da_load(qx, tid, Kg, Vg, kv, vv); DA_QLOAD(qx); }
        f32x4 s[10];
        int frq = fr, wq = w; asm volatile("" : "+v"(frq), "+v"(wq));
#pragma unroll
        for (int kb = 0; kb < 9; ++kb) { const int kbc = (w + kb) < 15 ? (w + kb) : 15; s[kb] = (f32x4){0.f, 0.f, 0.f, 0.f};
#pragma unroll
            for (int ks = 0; ks < 2; ++ks) { const bf16x8 a = *(const LAS bf16x8*)(lds + (16 * kbc + fr) * DA_KP + (32 * ks + 8 * fq) * 2); s[kb] = __builtin_amdgcn_mfma_f32_16x16x32_bf16(a, qf[ks], s[kb], 0, 0, 0); } }
        s[9] = (f32x4){NINF, NINF, NINF, NINF};
        float mx = NINF;
#pragma unroll
        for (int kb = 0; kb < 9; ++kb) { const bool blk_ok = (n > 0) || (wq + kb >= 8);
#pragma unroll
            for (int i = 0; i < 4; ++i) { const int jj = 4 * fq + i; bool ok = blk_ok; if (kb == 0) ok = ok && (frq <= jj); if (kb == 8) ok = ok && (jj <= frq);
                s[kb][i] = ok ? s[kb][i] : NINF; mx = fmaxf(mx, s[kb][i]); } }
        mx = fmaxf(mx, __shfl_xor(mx, 16)); mx = fmaxf(mx, __shfl_xor(mx, 32));
        float sm = 0.f;
#pragma unroll
        for (int kb = 0; kb < 10; ++kb)
#pragma unroll
            for (int i = 0; i < 4; ++i) { s[kb][i] = fexp2(s[kb][i] - mx); sm += s[kb][i]; }
        sm += __shfl_xor(sm, 16); sm += __shfl_xor(sm, 32);
        f32x4 o[4];
#pragma unroll
        for (int eb = 0; eb < 4; ++eb) o[eb] = (f32x4){0.f, 0.f, 0.f, 0.f};
#pragma unroll
        for (int c = 0; c < 5; ++c) { const int ka = (w + 2 * c) < 15 ? (w + 2 * c) : 15, kb2 = (w + 2 * c + 1) < 15 ? (w + 2 * c + 1) : 15;
            const u32x4 pw = pack8(s[2 * c], s[2 * c + 1]); const bf16x8 pb = __builtin_bit_cast(bf16x8, pw);
#pragma unroll
            for (int eb = 0; eb < 4; ++eb) {
                const LAS unsigned char* vr = lds + DA_VOFF + (4 * fq + (fr >> 2)) * DA_KP + (16 * eb + 4 * (fr & 3)) * 2;
                const u32x2 va = __builtin_bit_cast(u32x2, __builtin_amdgcn_ds_read_tr16_b64_v4i16((LAS s16x4*)(vr + 16 * ka * DA_KP)));
                const u32x2 vb = __builtin_bit_cast(u32x2, __builtin_amdgcn_ds_read_tr16_b64_v4i16((LAS s16x4*)(vr + 16 * kb2 * DA_KP)));
                const u32x4 vw = (u32x4){va.x, va.y, vb.x, vb.y};
                o[eb] = __builtin_amdgcn_mfma_f32_16x16x32_bf16(__builtin_bit_cast(bf16x8, vw), pb, o[eb], 0, 0, 0); } }
        const float inv = 1.f / sm;
#pragma unroll
        for (int eb = 0; eb < 4; ++eb) { u32x2 ow; ow.x = cvt_pk_bf16(o[eb][0] * inv, o[eb][1] * inv); ow.y = cvt_pk_bf16(o[eb][2] * inv, o[eb][3] * inv);
            *(u32x2*)(QO + rowq * DW + col0 + 16 * eb + 4 * fq) = ow; }
        if (fq == 0) LSE[rowq * 12 + q.g * 4 + q.h] = mx + __builtin_amdgcn_logf(sm);
    }
    __syncthreads();
#undef DA_QLOAD
}

constexpr int TH_XB = 0, TH_WOFF = 98304, TH_POFF = 131072;
__device__ __forceinline__ void thin_phase(const Ctx& F, const bf16* AG, const bf16* GB, const bf16* CP, const bf16* OG, const float* LSE,
                                           const float* acw, const float* acb, const float* lng, const float* lnb, const float* ccw, bf16* ACT) {
    const int tid = F.tid, w = F.wave, lane = F.lane;
    LAS unsigned char* lds = F.lds;
    for (int i = tid; i < 16 * CA; i += NTHR) { const int q = i >> 9, c = i & 511; const unsigned lo = f2bf(acw[(2 * q) * CA + c]), hi = (2 * q + 1 < CAK) ? f2bf(acw[(2 * q + 1) * CA + c]) : 0u;
        *(LAS unsigned*)(lds + TH_WOFF + q * 2048 + ((c & 4) ? 1024 : 0) + (c >> 3) * 16 + (c & 3) * 4) = lo | (hi << 16); }
    {   LAS float* prm = (LAS float*)(lds + TH_POFF);
        if (tid < CA) { prm[tid] = acb[tid]; prm[CA + tid] = lng[tid]; prm[2 * CA + tid] = lnb[tid]; prm[3 * CA + tid] = ccw[tid]; prm[4 * CA + tid] = ccw[CS + tid]; prm[5 * CA + tid] = ccw[2 * CS + tid]; } }
    const int cpart = tid & 63;
    __syncthreads();
    const int vb = (F.G % 8 == 0) ? (F.bid % 8) * (F.G / 8) + F.bid / 8 : F.bid;
    const bool a_first = (F.G % 16 == 0) ? (F.bid / 8 < F.G / 16) : ((F.bid & 1) == 0);
    u32x4 st[12];
#define ST_LOAD(s_) do { const int b_ = (s_) / (SEQ / 64), t0_ = ((s_) % (SEQ / 64)) * 64; const size_t rb_ = (size_t)b_ * SEQ; \
          \
        _Pragma("unroll") for (int i = 0; i < 6; ++i) { const int c = tid + NTHR * i, pp = c >> 6, part = c & 63, tt = t0_ - 30 + 2 * pp; \
            const int ta_ = tt < 0 ? 0 : (tt > t0_ + 63 ? t0_ + 63 : tt), tb_ = tt + 1 < 0 ? 0 : (tt + 1 > t0_ + 63 ? t0_ + 63 : tt + 1); \
            st[2 * i] = *(const u32x4*)(AG + (rb_ + ta_) * CA + part * 8); st[2 * i + 1] = *(const u32x4*)(AG + (rb_ + tb_) * CA + part * 8); } \
        _Pragma("unroll") for (int i = 0; i < 6; ++i) { const int c = tid + NTHR * i, pp = c >> 6, tt = t0_ - 30 + 2 * pp; \
            if (tt < 0) st[2 * i] = (u32x4){0u, 0u, 0u, 0u}; if (tt + 1 < 0) st[2 * i + 1] = (u32x4){0u, 0u, 0u, 0u}; } } while (0)
#define CP_LOAD(i0) do { _Pragma("unroll") for (int i = 0; i < 4; ++i) { const int tok = (tid >> 6) + 8 * ((i0) + i), t = t0 + tok; const size_t row = rb + t; \
            cg[i] = *(const u32x4*)(GB + row * CS + cpart * 8); c0w[i] = *(const u32x4*)(CP + row * CS + cpart * 8); c1w[i] = (u32x4){0u, 0u, 0u, 0u}; c2w[i] = (u32x4){0u, 0u, 0u, 0u}; \
            if (t >= 1) c1w[i] = *(const u32x4*)(CP + (row - 1) * CS + cpart * 8); if (t >= 2) c2w[i] = *(const u32x4*)(CP + (row - 2) * CS + cpart * 8); } } while (0)
#define CP_DO(i0) do { int pc_ = cpart * 32; asm volatile("" : "+v"(pc_)); const LAS unsigned char* pw_ = lds + TH_POFF + 3 * CA * 4 + pc_; \
        const f32x4 wa0 = *(const LAS f32x4*)(pw_), wa1 = *(const LAS f32x4*)(pw_ + 16), wb0 = *(const LAS f32x4*)(pw_ + CA * 4), wb1 = *(const LAS f32x4*)(pw_ + CA * 4 + 16), \
                    wc0 = *(const LAS f32x4*)(pw_ + 2 * CA * 4), wc1 = *(const LAS f32x4*)(pw_ + 2 * CA * 4 + 16); \
        _Pragma("unroll") for (int i = 0; i < 4; ++i) { const int tok = (tid >> 6) + 8 * ((i0) + i); const size_t row = rb + t0 + tok; \
            f32x4 g0, g1, p0, p1, q0, q1, r0, r1; unpack8(cg[i], g0, g1); unpack8(c0w[i], p0, p1); unpack8(c1w[i], q0, q1); unpack8(c2w[i], r0, r1); \
            const f32x4 y0 = g0 * (wc0 * p0 + wb0 * q0 + wa0 * r0), y1 = g1 * (wc1 * p1 + wb1 * q1 + wa1 * r1); \
            *(u32x4*)(ACT + row * KCAT + 768 + cpart * 8) = pack8(y0, y1); } } while (0)
#pragma nounroll
#ifndef MK_THIN_X
#define MK_THIN_X 0
#endif
    for (int pass = 0; pass < (MK_THIN_X ? 3 : 2); ++pass) {
        const bool do_a = pass == 2 ? (MK_THIN_X == 1) : ((pass == 0) == a_first);
        if (do_a) {
#pragma nounroll
            for (int s = vb; s < M / 64; s += F.G) {
                const int b = s / (SEQ / 64), t0 = (s % (SEQ / 64)) * 64; const size_t rb = (size_t)b * SEQ;
                ST_LOAD(s);
#pragma unroll
                for (int i = 0; i < 6; ++i) { const int c = tid + NTHR * i, pp = c >> 6, part = c & 63; const u32x4 ra = st[2 * i], rc = st[2 * i + 1];
                    if (pp < 47) {
                        *(LAS u32x4*)(lds + TH_XB + pp * 2048 + part * 16) = (u32x4){__builtin_amdgcn_perm(rc.x, ra.x, 0x05040100u), __builtin_amdgcn_perm(rc.x, ra.x, 0x07060302u), __builtin_amdgcn_perm(rc.y, ra.y, 0x05040100u), __builtin_amdgcn_perm(rc.y, ra.y, 0x07060302u)};
                        *(LAS u32x4*)(lds + TH_XB + pp * 2048 + 1024 + part * 16) = (u32x4){__builtin_amdgcn_perm(rc.z, ra.z, 0x05040100u), __builtin_amdgcn_perm(rc.z, ra.z, 0x07060302u), __builtin_amdgcn_perm(rc.w, ra.w, 0x05040100u), __builtin_amdgcn_perm(rc.w, ra.w, 0x07060302u)}; } }
                __syncthreads();
                asm volatile("" ::: "memory");
                {
                    int po = lane * 32; asm volatile("" : "+v"(po));
                    f32x4 cb[2], lg[2], lb[2];
#pragma unroll
                    for (int q = 0; q < 2; ++q) cb[q] = *(const LAS f32x4*)(lds + TH_POFF + po + 16 * q);
                    f32x4 acc[8][2];
#pragma unroll
                    for (int j = 0; j < 8; ++j) { acc[j][0] = cb[0]; acc[j][1] = cb[1]; }
                    u32x4 pva = (u32x4){0u, 0u, 0u, 0u}, pvb = pva;
#define D2(x_, w_, a_) a_ = __builtin_amdgcn_fdot2_f32_bf16(__builtin_bit_cast(bf16x2_t, (unsigned)(x_)), __builtin_bit_cast(bf16x2_t, (unsigned)(w_)), a_, false)
#pragma nounroll
                    for (int q = 0; q < 16; ++q) {
                        const u32x4 va = *(const LAS u32x4*)(lds + TH_WOFF + q * 2048 + lane * 16), vb = *(const LAS u32x4*)(lds + TH_WOFF + q * 2048 + 1024 + lane * 16);
                        u32x4 ua, ub;
#pragma unroll
                        for (int e = 0; e < 4; ++e) { ua[e] = __builtin_amdgcn_alignbit(va[e], pva[e], 16); ub[e] = __builtin_amdgcn_alignbit(vb[e], pvb[e], 16); }
#pragma unroll
                        for (int m = 0; m < 4; ++m) { const u32x4 xa = *(const LAS u32x4*)(lds + TH_XB + (4 * w + m + q) * 2048 + lane * 16), xb = *(const LAS u32x4*)(lds + TH_XB + (4 * w + m + q) * 2048 + 1024 + lane * 16);
#pragma unroll
                            for (int e = 0; e < 4; ++e) { D2(xa[e], va[e], acc[2 * m][0][e]); D2(xb[e], vb[e], acc[2 * m][1][e]); D2(xa[e], ua[e], acc[2 * m + 1][0][e]); D2(xb[e], ub[e], acc[2 * m + 1][1][e]); } }
                        pva = va; pvb = vb; }
#undef D2
#pragma unroll
                    for (int q = 0; q < 2; ++q) { lg[q] = *(const LAS f32x4*)(lds + TH_POFF + CA * 4 + po + 16 * q); lb[q] = *(const LAS f32x4*)(lds + TH_POFF + 2 * CA * 4 + po + 16 * q); }
#pragma unroll
                    for (int j = 0; j < 8; ++j) { const f32x4 a0 = acc[j][0], a1 = acc[j][1];
                        const float mean = wave_sum((a0[0] + a0[1]) + (a0[2] + a0[3]) + (a1[0] + a1[1]) + (a1[2] + a1[3])) * (1.f / CA);
                        const f32x4 d0 = a0 - mean, d1 = a1 - mean;
                        const float var = wave_sum((d0[0] * d0[0] + d0[1] * d0[1]) + (d0[2] * d0[2] + d0[3] * d0[3]) + (d1[0] * d1[0] + d1[1] * d1[1]) + (d1[2] * d1[2] + d1[3] * d1[3])) * (1.f / CA);
                        const float rs = __builtin_amdgcn_rsqf(var + EPS);
                        f32x4 y0 = d0 * rs * lg[0] + lb[0], y1 = d1 * rs * lg[1] + lb[1];
#pragma unroll
                        for (int q = 0; q < 4; ++q) { y0[q] *= sigmoidf_(y0[q]); y1[q] *= sigmoidf_(y1[q]); }
                        *(u32x4*)(ACT + (rb + t0 + 8 * w + j) * KCAT + 8 * lane) = pack8(y0, y1); }
                }
                __syncthreads();
            }
        } else {
#pragma nounroll
            for (int s = vb; s < M / 64; s += F.G) {
                const int b = s / (SEQ / 64), t0 = (s % (SEQ / 64)) * 64; const size_t rb = (size_t)b * SEQ;
                u32x4 cg[4], c0w[4], c1w[4], c2w[4];
                float ml[4][3]; u32x4 mo[4][3];
                CP_LOAD(0);
#pragma unroll
                for (int i = 0; i < 4; ++i) { const int idx = tid + NTHR * i, tok = idx >> 5, h = (idx >> 3) & 3, part = idx & 7; const size_t row = rb + t0 + tok;
                    ml[i][0] = LSE[row * 12 + h]; ml[i][1] = LSE[row * 12 + 4 + h]; ml[i][2] = LSE[row * 12 + 8 + h];
                    const bf16* op = OG + row * DW + h * 64 + part * 8; mo[i][0] = *(const u32x4*)op; mo[i][1] = *(const u32x4*)(op + 256); mo[i][2] = *(const u32x4*)(op + 512); }
                asm volatile("" ::: "memory");
                CP_DO(0);
#pragma unroll
                for (int i = 0; i < 4; ++i) { const int idx = tid + NTHR * i, tok = idx >> 5, h = (idx >> 3) & 3, part = idx & 7; const size_t row = rb + t0 + tok;
                    const float mx = fmaxf(ml[i][0], fmaxf(ml[i][1], ml[i][2]));
                    float w0 = fexp2(ml[i][0] - mx), w1 = fexp2(ml[i][1] - mx), w2 = fexp2(ml[i][2] - mx); const float inv = 1.f / (w0 + w1 + w2); w0 *= inv; w1 *= inv; w2 *= inv;
                    f32x4 a0, a1, b0, b1, e0, e1; unpack8(mo[i][0], a0, a1); unpack8(mo[i][1], b0, b1); unpack8(mo[i][2], e0, e1);
                    *(u32x4*)(ACT + row * KCAT + 512 + h * 64 + part * 8) = pack8(a0 * w0 + b0 * w1 + e0 * w2, a1 * w0 + b1 * w1 + e1 * w2); }
                asm volatile("" ::: "memory");
                CP_LOAD(4);
                CP_DO(4);
            }
        }
    }
    __syncthreads();
#undef ST_LOAD
#undef CP_LOAD
#undef CP_DO
}

__device__ __forceinline__ void wave_sum8(float (&v)[8], int lane) {
    float a[4], b[2], c;
    {   const bool hi = (lane & 1) != 0;
#pragma unroll
        for (int i = 0; i < 4; ++i) { const float give = hi ? v[i] : v[i + 4], keep = hi ? v[i + 4] : v[i]; a[i] = keep + __shfl_xor(give, 1); } }
    {   const bool hi = (lane & 2) != 0;
#pragma unroll
        for (int i = 0; i < 2; ++i) { const float give = hi ? a[i] : a[i + 2], keep = hi ? a[i + 2] : a[i]; b[i] = keep + __shfl_xor(give, 2); } }
    {   const bool hi = (lane & 4) != 0; const float give = hi ? b[0] : b[1], keep = hi ? b[1] : b[0]; c = keep + __shfl_xor(give, 4); }
    c += __shfl_xor(c, 8); c += __shfl_xor(c, 16); c += __shfl_xor(c, 32);
#pragma unroll
    for (int e = 0; e < 8; ++e) { const int src = ((e >> 2) & 1) | (((e >> 1) & 1) << 1) | ((e & 1) << 2); v[e] = __builtin_bit_cast(float, __builtin_amdgcn_readlane(__builtin_bit_cast(int, c), src)); }
}
#if defined(MK_TIMING) && MK_TIMING
constexpr int TS_OFF_EARLY = 131072 + 16384 + 1024 + 256;
#define PSTAMP(F_, i) do { if (((i) == MK_TB0 || (i) == MK_TB1) && threadIdx.x == 0) ((volatile LAS unsigned long long*)((F_).lds + TS_OFF_EARLY))[(i) == MK_TB0 ? 0 : 1] = __builtin_amdgcn_s_memrealtime(); } while (0)
#else
#define PSTAMP(F_, i) do { } while (0)
#endif
__device__ __forceinline__ void router_phase(const Ctx& F, const bf16* xb, const u64* ss, const float* g, const float* wr, unsigned char* rt, gu32* cnt, unsigned char* x8n) {
    const int tid = F.tid, w = F.wave, lane = F.lane;
    LAS int* hist = (LAS int*)F.lds;
    int* RE = (int*)(rt + RT_E); float* RW = (float*)(rt + RT_W); float* RS = (float*)(rt + RT_RS); int* POS = (int*)(rt + RT_POS); int* BB = (int*)(rt + RT_BB);
    PSTAMP(F, 100);
    f32x4 wreg[2][8][2];
#pragma unroll
    for (int jj = 0; jj < 2; ++jj) { const int k0 = 8 * lane + 512 * jj; const f32x4 g0 = *(const f32x4*)(g + k0), g1 = *(const f32x4*)(g + k0 + 4);
        f32x4 t[8][2];
#pragma unroll
        for (int c = 0; c < 8; ++c) { t[c][0] = *(const f32x4*)(wr + (size_t)(k0 + c) * NE); t[c][1] = *(const f32x4*)(wr + (size_t)(k0 + c) * NE + 4); }
#pragma unroll
        for (int e = 0; e < 8; ++e) { wreg[jj][e][0] = (f32x4){t[0][e >> 2][e & 3] * g0[0], t[1][e >> 2][e & 3] * g0[1], t[2][e >> 2][e & 3] * g0[2], t[3][e >> 2][e & 3] * g0[3]};
                                      wreg[jj][e][1] = (f32x4){t[4][e >> 2][e & 3] * g1[0], t[5][e >> 2][e & 3] * g1[1], t[6][e >> 2][e & 3] * g1[2], t[7][e >> 2][e & 3] * g1[3]}; } }
    PSTAMP(F, 101);
    for (int vb = F.bid; vb < 256; vb += F.G) {
        if (tid < 16) hist[tid] = 0;
        __syncthreads();
        u32x4 xcur[2][2], xnxt[2][2]; u64 scur[2], snxt[2];
#define RT_LOAD(X_, S_, j0_) do { _Pragma("unroll") for (int q_ = 0; q_ < 2; ++q_) { const int t_ = vb * 128 + 16 * w + (j0_) + q_; const u32x4* xr_ = (const u32x4*)(xb + (size_t)t_ * D) + lane; X_[q_][0] = xr_[0]; X_[q_][1] = xr_[64]; S_[q_] = ss[t_]; } } while (0)
        RT_LOAD(xcur, scur, 0);
#pragma unroll
        for (int j = 0; j < 16; ++j) { const int tok = vb * 128 + 16 * w + j;
            if ((j & 1) == 0 && j + 2 < 16) RT_LOAD(xnxt, snxt, j + 2);
            float lg[8];
#pragma unroll
            for (int e = 0; e < 8; ++e) lg[e] = 0.f;
#pragma unroll
            for (int jj = 0; jj < 2; ++jj) { f32x4 v0, v1; unpack8(xcur[j & 1][jj], v0, v1);
#pragma unroll
                for (int e = 0; e < 8; ++e) lg[e] += ((v0[0] * wreg[jj][e][0][0] + v0[1] * wreg[jj][e][0][1]) + (v0[2] * wreg[jj][e][0][2] + v0[3] * wreg[jj][e][0][3]))
                                                   + ((v1[0] * wreg[jj][e][1][0] + v1[1] * wreg[jj][e][1][1]) + (v1[2] * wreg[jj][e][1][2] + v1[3] * wreg[jj][e][1][3])); }
            const float rs = __builtin_amdgcn_rsqf((float)scur[j & 1] * (1.f / (SS_SCALE * D)) + EPS);
#pragma unroll
            for (int jj = 0; jj < 2; ++jj) { f32x4 v0, v1; unpack8(xcur[j & 1][jj], v0, v1); *(u32x2*)(x8n + (size_t)tok * D + 512 * jj + 8 * lane) = pack8_fp8(v0 * rs, v1 * rs); }
            if ((j & 1) == 1) {
#pragma unroll
                for (int q_ = 0; q_ < 2; ++q_) { xcur[q_][0] = xnxt[q_][0]; xcur[q_][1] = xnxt[q_][1]; scur[q_] = snxt[q_]; } }
            wave_sum8(lg, lane);
#pragma unroll
            for (int e = 0; e < 8; ++e) lg[e] *= rs;
            int e1 = 0; float v1 = lg[0];
#pragma unroll
            for (int e = 1; e < 8; ++e) if (lg[e] > v1) { v1 = lg[e]; e1 = e; }
            int e2 = -1; float v2 = -3.0e38f;
#pragma unroll
            for (int e = 0; e < 8; ++e) if (e != e1 && lg[e] > v2) { v2 = lg[e]; e2 = e; }
            const float w1 = 1.f / (1.f + __expf(v2 - v1)), w2 = 1.f - w1;
            if (lane == 0) { const int r1 = atomicAdd((int*)(hist + e1), 1), r2 = atomicAdd((int*)(hist + 8 + e2), 1);
                RE[tok] = e1 | (e2 << 8); RW[2 * tok] = w1; RW[2 * tok + 1] = w2; RS[tok] = rs; POS[2 * tok] = r1; POS[2 * tok + 1] = r2; } }
#undef RT_LOAD
        PSTAMP(F, 102);
        __syncthreads();
        if (tid < 16) { const int c = hist[tid]; int base = 0; if (c > 0) base = (int)__hip_atomic_fetch_add(cnt + 64 * tid, (unsigned)c, RLX_AGENT); BB[vb * 16 + tid] = base; }
        __syncthreads();
    }
    PSTAMP(F, 103);
}
__device__ __forceinline__ int tbsel(const pol::MoeTiles& mt, int p, int e) { int t = 0;
#pragma unroll
    for (int k = 0; k < 8; ++k) t = (k == e) ? (p ? mt.tb[1][k] : mt.tb[0][k]) : t;
    return t; }
__device__ __forceinline__ void lists_phase(const Ctx& F, unsigned char* rt, const unsigned* cnt) {
    const int* RE = (const int*)(rt + RT_E); const float* RW = (const float*)(rt + RT_W); const float* RS = (const float*)(rt + RT_RS); const int* POS = (const int*)(rt + RT_POS); const int* BB = (const int*)(rt + RT_BB);
    int* LIST = (int*)(rt + RT_LIST); float* LW = (float*)(rt + RT_LW); float* LR = (float*)(rt + RT_LR); int* SL = (int*)(rt + RT_SL);
    pol::MoeTiles mt; mt.init(cnt);
    const int gt = F.bid * NTHR + F.tid, NT = F.G * NTHR;
    for (int tok = gt; tok < M; tok += NT) { const int ee = RE[tok], vb = tok >> 7; const float rs = RS[tok];
#pragma unroll
        for (int p = 0; p < 2; ++p) { const int e = (ee >> (8 * p)) & 255; const int tb = tbsel(mt, p, e);
            const int slot = p * MOE_ROWS + 256 * tb + BB[vb * 16 + p * 8 + e] + POS[2 * tok + p];
            LIST[slot] = tok; LW[slot] = RW[2 * tok + p]; LR[slot] = rs; SL[p * M + tok] = slot; } }
    for (int idx = gt; idx < 2 * 8 * 256; idx += NT) { const int p = idx >> 11, e = (idx >> 8) & 7, i = idx & 255; const int c = (int)cnt[64 * (p * 8 + e)], rem = c & 255;
        if (rem != 0 && i >= rem) { const int tb = tbsel(mt, p, e); const int slot = p * MOE_ROWS + 256 * (tb + (c >> 8)) + i;
            LIST[slot] = -1; LW[slot] = 0.f; LR[slot] = 0.f; } }
}
#ifndef MK_FFN_UP_FP8
#define MK_FFN_UP_FP8 0
#endif
#ifndef MK_TIMING
#define MK_TIMING 0
#endif
constexpr int RING_BYTES = 131072, XCH_OFF = RING_BYTES, MISC_OFF = XCH_OFF + 16384 + 1024, TS_OFF = MISC_OFF + 256, LDS_BYTES = TS_OFF + 256;
constexpr int NPH = 23;
struct Args { const float* in[29]; float* out; unsigned char* ws; int ph_lo, ph_hi; };

__global__ void __launch_bounds__(NTHR, 2) mk_fwd(Args args) {
    extern __shared__ __attribute__((aligned(16))) unsigned char lds_raw[];
    typedef const __attribute__((address_space(4))) Args* KArgs;
#define KA_ ({ KArgs k_ = (KArgs)__builtin_amdgcn_kernarg_segment_ptr(); asm volatile("" : "+s"(k_)); k_; })
#define LDSB ((LAS unsigned char*)lds_raw)
#define MK_CTX(F) Ctx F; F.lds = LDSB; F.tid = threadIdx.x; asm volatile("" : "+v"(F.tid)); F.lane = F.tid & 63; F.wave = __builtin_amdgcn_readfirstlane(F.tid >> 6); \
    F.G = gridDim.x; F.bid = blockIdx.x; F.gw = F.bid * NWAVES + F.wave; F.NGW = F.G * NWAVES;
    {   volatile LAS unsigned* MISC = (volatile LAS unsigned*)(LDSB + MISC_OFF);
        if (threadIdx.x < 64) MISC[threadIdx.x] = 0u;
        __syncthreads();
        if (args.ph_hi - args.ph_lo > 1) (void)xcd_barrier_post((unsigned*)(args.ws + WS_CTL) + CW_BAR, MISC + 8); }
#if MK_TIMING
#define STAMP(i) do { if (((i) == MK_TB0 || (i) == MK_TB1) && threadIdx.x == 0) ((volatile LAS unsigned long long*)(LDSB + TS_OFF))[(i) == MK_TB0 ? 0 : 1] = __builtin_amdgcn_s_memrealtime(); } while (0)
    STAMP(0);
#else
#define STAMP(i) do { } while (0)
#endif
#define PHASE_ARGS MK_CTX(F) KArgs ka = KA_; unsigned char* ws = ka->ws; unsigned char* R1 = ws + WS_R1; (void)R1;
#define INP(k) (ka->in[k])
#ifndef MK_MASK
#define MK_MASK 0xFFFFFFFFu
#endif
#define EN(s) (((MK_MASK) >> (s)) & 1u)
#define IN(k) ({ KArgs q_ = KA_; q_->ph_lo <= (k) && (k) < q_->ph_hi; })
#define SEAM(k) do { if (IN(k) && IN((k) + 1)) { XcdBarrier b2_; b2_.bar = (unsigned*)(KA_->ws + WS_CTL) + CW_BAR; b2_.x = xb_xcc_id(); b2_.st = (volatile LAS unsigned*)(LDSB + MISC_OFF) + 8; xcd_barrier(b2_); STAMP((k) + 1); } } while (0)
#define ring LDSB
#define MOE_CONV(e0, e1) do { int rot_ = 0; for (int e = (e0); e < (e1); ++e) { \
        tr_matrix<2, true>(F, rot_, INP(25) + (size_t)e * D * MFF, INP(26) + (size_t)e * D * MFF, D, 2 * MFF, MFF, (bf16*)(R1 + R_MW13 + (size_t)e * 2 * MFF * D), D, 0, INP(20) + D); \
        tr_matrix<0, true>(F, rot_, INP(27) + (size_t)e * MFF * D, nullptr, MFF, D, D, (bf16*)(R1 + R_MW2 + (size_t)e * D * MFF), MFF, 0, nullptr); } } while (0)
#ifndef MK_STAG_Z
#define MK_STAG_Z 0
#endif
#define STAGGER(ticks) do { if ((ticks) > 0 && (blockIdx.x & 1)) { const unsigned long long t0_ = __builtin_amdgcn_s_memrealtime(); while (__builtin_amdgcn_s_memrealtime() - t0_ < (unsigned long long)(ticks)) __builtin_amdgcn_s_sleep(8); } } while (0)
#define SSP ((u64*)(ws + WS_SS))
#define XBP ((bf16*)(ws + WS_XB))
#define OUTP (ka->out)

    if (EN(0) && IN(0)) { PHASE_ARGS int rot = 0;
        for (int l = 0; l < 2; ++l) {
            unsigned char* wl = ws + WS_W + (size_t)l * W_LAYER;
            if (NZB) tr_matrix<1>(F, rot, INP(3) + (size_t)l * D * NIN, nullptr, D, NZB, NIN, (bf16*)(wl + W_WIN), D, 0, INP(2) + l * D);
            tr_matrix<3, true>(F, rot, INP(3) + (size_t)l * D * NIN, nullptr, D, NZ8, NIN, (bf16*)(wl + W_WIN8), D, 0, INP(2) + l * D);
            tr_matrix<0>(F, rot, INP(9) + (size_t)l * CA * D, nullptr, CA, D, D, (bf16*)(wl + W_WCAT), KCAT, 0, nullptr);
            tr_matrix<0>(F, rot, INP(10) + (size_t)l * DO * D, nullptr, DO, D, D, (bf16*)(wl + W_WCAT), KCAT, 512, nullptr);
            tr_matrix<0>(F, rot, INP(12) + (size_t)l * CS * D, nullptr, CS, D, D, (bf16*)(wl + W_WCAT), KCAT, 768, nullptr);
            tr_matrix<0>(F, rot, INP(13) + (size_t)l * D * D, nullptr, D, D, D, (bf16*)(wl + W_WO), D, 0, nullptr);
            bf16* wkv = (bf16*)(R1 + R_WKV) + (size_t)l * 2048 * D;
            tr_matrix<0>(F, rot, INP(17) + (size_t)l * D * D, nullptr, D, D, D, wkv, D, 0, nullptr);
            tr_matrix<0>(F, rot, INP(18) + (size_t)l * D * D, nullptr, D, D, D, wkv + (size_t)D * D, D, 0, nullptr);
            tr_matrix<0>(F, rot, INP(19) + (size_t)l * D * D, nullptr, D, D, D, (bf16*)(R1 + R_WOT) + (size_t)l * D * D, D, 0, nullptr);
            cv_rows(F, INP(16) + (size_t)l * D * D, (bf16*)(R1 + R_WQ) + (size_t)l * D * D, D, INP(14) + l * D, CX);
            rows_rmsnorm_bf16(F, INP(1), INP(15) + l * D, (bf16*)(R1 + R_MN) + (size_t)l * 512 * D, NB * MEM);
            float* bz = (float*)(ws + WS_BZ) + l * NIN; const float* bi = INP(4) + l * NIN;
            for (int n = F.bid * NTHR + F.tid; n < NIN; n += F.G * NTHR) bz[n] = bi[n < NZB ? zmapB(n) : zmap8(n - NZB)];
        }
        #if MK_FFN_UP_FP8
        tr_matrix<2, true>(F, rot, INP(21), INP(22), D, 2 * DFF, DFF, (bf16*)(ws + WS_WFF + WFF_W13), D, 0, INP(20));
#else
        tr_matrix<2>(F, rot, INP(21), INP(22), D, 2 * DFF, DFF, (bf16*)(ws + WS_WFF + WFF_W13), D, 0, INP(20));
#endif
#if MK_FFN_DOWN_FP8
        tr_matrix<0, true>(F, rot, INP(23), nullptr, DFF, D, D, (bf16*)(ws + WS_WFF + WFF_W2), DFF, 0, nullptr);
#else
        tr_matrix<0>(F, rot, INP(23), nullptr, DFF, D, D, (bf16*)(ws + WS_WFF + WFF_W2), DFF, 0, nullptr);
#endif
        rows_raw_ss(F, INP(0), XBP, ws + WS_X8, SSP);
    }
    SEAM(0);
    for (int l = 0; l < 2; ++l) {
        const int pb = l == 0 ? 1 : 10;
#define WL (ws + WS_W + (size_t)l * W_LAYER)
#define AGP ((bf16*)(R1 + R_AG))
#define GBP ((bf16*)(R1 + R_GB))
#define CPP ((bf16*)(R1 + R_CP))
#define QP ((bf16*)(R1 + R_Q))
#define KP ((bf16*)(R1 + R_K))
#define VP ((bf16*)(R1 + R_V))
#define GTP ((const unsigned char*)(R1 + R_G))
#define ACTP ((bf16*)(R1 + R_ACT))
#define MRGP ((bf16*)(R1 + R_MRG))
#define PBP ((bf16*)(R1 + R_P))
#define LSEP ((float*)(ws + WS_LSE))
#define SSA (SSP + (size_t)(3 * l) * M)
        if (EN(4) && IN(pb + 0)) { PHASE_ARGS
            STAGGER(MK_STAG_Z);
            {   const float* bzg = (const float*)(ws + WS_BZ) + l * NIN; LAS bf16* bzl = (LAS bf16*)(LDSB + XCH_OFF + 1024);
                for (int i = F.tid; i < NIN; i += NTHR) bzl[i] = (bf16)f2bf(bzg[i]);
                __syncthreads(); }
            {   pol::PolZ8 p; p.init(M / 256, NZ8 / 256, F.G, F.bid);
                p.A = (const char*)(ws + WS_X8); p.Bt = (const char*)(WL + W_WIN8); p.ss = SSA; p.bzl = (LAS bf16*)(LDSB + XCH_OFF + 1024) + NZB; p.R1 = R1; p.rsl = (LAS float*)(LDSB + XCH_OFF); p.cpm = -1;
                pg8::gemm_phase<pol::PolZ8, true>(ring, p); }
            if (NZB) {   pol::PolZB p; p.init(M / 256, NZB / 256, F.G, F.bid);
                p.A = (const char*)XBP; p.Bt = (const char*)(WL + W_WIN); p.ss = SSA; p.bzl = (LAS bf16*)(LDSB + XCH_OFF + 1024); p.R1 = R1; p.rsl = (LAS float*)(LDSB + XCH_OFF); p.cpm = -1;
                pg8::gemm_phase<pol::PolZB, true>(ring, p); }
            if (l == 0 && EN(1)) {
                pol::PolPlain p; p.init(4, 8, F.G, F.bid >= F.G / 2 ? F.bid - F.G / 2 : (1 << 20));
                p.A = (const char*)(R1 + R_MN); p.Bt = (const char*)(R1 + R_WKV); p.C = (char*)(R1 + R_KM); p.lda_ = 2048; p.ldb_ = 2048; p.ldc_ = 4096; p.nt_ = 16;
                p.mper = 2; p.n0 = 1; p.n1 = 1; p.a0 = p.a1 = 0; p.a2 = (size_t)512 * 2048; p.b0 = p.b1 = 0; p.b2 = (size_t)2048 * 2048; p.c0 = p.c1 = 0; p.c2 = (size_t)512 * 4096;
                pg8::gemm_phase<pol::PolPlain, true>(ring, p); }
        }
        SEAM(pb + 0);
        if (EN(5) && IN(pb + 1)) { PHASE_ARGS
            if (l == 1 && F.bid < F.G / 2) { MOE_CONV(0, NE / 2); __syncthreads(); }
            dil_attn_phase(F, QP, KP, VP, LSEP);
            if (l == 1 && F.bid >= F.G / 2) { __syncthreads(); MOE_CONV(0, NE / 2); }
            if (l == 0) {
                __syncthreads();
                if (EN(2)) {   pol::PolPlain8 p; p.init(16, 4, F.G, F.bid >= F.G / 2 ? F.bid - F.G / 2 : (1 << 20));
                    p.A = (const char*)(R1 + R_KM); p.Bt = (const char*)(R1 + R_WQ); p.C = (char*)(ws + WS_WQK); p.lda_ = 4096; p.ldb_ = 2048; p.ldc_ = 1024; p.nt_ = 4;
                    p.mper = 1; p.n0 = 4; p.n1 = 2; p.a0 = 512; p.a1 = (size_t)256 * 4096; p.a2 = (size_t)512 * 4096; p.b0 = 512; p.b1 = 0; p.b2 = (size_t)D * 2048;
                    p.c0 = (size_t)256 * 1024; p.c1 = (size_t)D * 1024; p.c2 = (size_t)2 * D * 1024;
                    pg8::gemm_phase<pol::PolPlain8, true>(ring, p); }
                if (EN(3)) {   pol::PolPlain8 p; p.init(64, 1, F.G, F.bid >= F.G / 2 + 64 ? F.bid - F.G / 2 - 64 : (1 << 20));
                    p.A = (const char*)(R1 + R_WOT); p.Bt = (const char*)(R1 + R_KM) + 2048; p.C = (char*)(ws + WS_WVO); p.lda_ = 2048; p.ldb_ = 4096; p.ldc_ = 1024; p.nt_ = 4;
                    p.mper = 4; p.n0 = 4; p.n1 = 2; p.a0 = 512; p.a1 = 0; p.a2 = (size_t)D * 2048; p.b0 = 512; p.b1 = (size_t)256 * 4096; p.b2 = (size_t)512 * 4096;
                    p.c0 = 256; p.c1 = (size_t)D * 1024; p.c2 = (size_t)2 * D * 1024;
                    pg8::gemm_phase<pol::PolPlain8, true>(ring, p); }
            }
        }
        SEAM(pb + 1);
        if (EN(6) && IN(pb + 2)) { PHASE_ARGS
            if (l == 1 && F.bid < F.G / 2) { MOE_CONV(NE / 2, NE); __syncthreads(); }
            thin_phase(F, AGP, GBP, CPP, QP, LSEP, INP(5) + l * CAK * CA, INP(6) + l * CA, INP(7) + l * CA, INP(8) + l * CA, INP(11) + l * 3 * CS, ACTP);
            if (l == 1 && F.bid >= F.G / 2) { __syncthreads(); MOE_CONV(NE / 2, NE); } }
        SEAM(pb + 2);
        if (EN(7) && IN(pb + 3)) { PHASE_ARGS
            pol::PolMerge p; p.init(M / 256, 4, F.G, F.bid);
            p.A = (const char*)ACTP; p.Bt = (const char*)(WL + W_WCAT); p.Gt = GTP; p.MRG = MRGP;
            pg8::gemm_phase<pol::PolMerge, true>(ring, p);
        }
        SEAM(pb + 3);
        if (EN(8) && IN(pb + 4)) { PHASE_ARGS
            pol::PolRes p; p.init(M / 256, 4, F.G, F.bid);
            p.A = (const char*)MRGP; p.Bt = (const char*)(WL + W_WO); p.b_batch = 0; p.K = D; p.XB = XBP; p.ssn = SSA + (size_t)M; p.X8 = ws + WS_X8; p.ascale = 1.f;
            pg8::gemm_phase<pol::PolRes, true>(ring, p);
        }
        SEAM(pb + 4);
        if (EN(9) && IN(pb + 5)) { PHASE_ARGS
            pol::PolXS p; p.init(M / 256, 4, F.G, F.bid);
            p.A = (const char*)(ws + WS_X8); p.Bt = (const char*)(ws + WS_WQK) + (size_t)l * 2 * D * 1024; p.b_batch = (size_t)D * 1024; p.ss = SSA + (size_t)M; p.P = R1 + R_P; p.xch = (LAS float*)(F.lds + XCH_OFF); p.parity = 0;
            pg8::gemm_phase<pol::PolXS, true>(ring, p);
        }
        SEAM(pb + 5);
        if (EN(10) && IN(pb + 6)) { PHASE_ARGS
            pol::PolRes8 p; p.init(M / 256, 4, F.G, F.bid);
            p.A = (const char*)(R1 + R_P); p.Bt = (const char*)(ws + WS_WVO) + (size_t)l * 2 * D * 1024; p.b_batch = (size_t)D * 1024; p.K = D; p.XB = XBP; p.ssn = SSA + (size_t)2 * M; p.X8 = (l == 0 && MK_FFN_UP_FP8) ? ws + WS_X8 : nullptr; p.ascale = W8_INV * W8_INV;
            pg8::gemm_phase<pol::PolRes8, true>(ring, p);
        }
        SEAM(pb + 6);
        if (l == 0) {
            if (EN(11) && IN(pb + 7)) { PHASE_ARGS
#if MK_FFN_UP_FP8
                typedef pol::PolUp PolUpX; const char* upA = (const char*)(ws + WS_X8);
#else
                typedef pol::PolUpB PolUpX; const char* upA = (const char*)XBP;
#endif
                PolUpX p; p.init(M / 256, 2 * DFF / 256, F.G, F.bid);
                p.A = upA;
                p.out16 = !MK_FFN_DOWN_FP8; p.rsl = (LAS float*)(LDSB + XCH_OFF); p.cpm = -1;
                p.Bt = (const char*)(ws + WS_WFF + WFF_W13); p.ss = SSA + (size_t)2 * M; p.U = R1 + R_U;
                pg8::gemm_phase<PolUpX, true>(ring, p);
            }
            SEAM(pb + 7);
            if (EN(12) && IN(pb + 8)) { PHASE_ARGS
#if MK_FFN_DOWN_FP8
                typedef pol::PolRes8 PolDownX; const float dsc = W8_INV;
#else
                typedef pol::PolRes PolDownX; const float dsc = 1.f;
#endif
                PolDownX p; p.init(M / 256, 4, F.G, F.bid);
                p.A = (const char*)(R1 + R_U); p.Bt = (const char*)(ws + WS_WFF + WFF_W2); p.b_batch = 0; p.K = DFF; p.XB = XBP; p.ssn = SSP + (size_t)3 * M; p.X8 = ws + WS_X8; p.ascale = dsc;
                pg8::gemm_phase<PolDownX, true>(ring, p);
            }
            SEAM(pb + 8);
        } else {
#define RTP (ws + WS_RT)
#define CNTP ((gu32*)(ws + WS_CTL) + CW_CNT)
            if (EN(13) && IN(pb + 7)) { PHASE_ARGS router_phase(F, XBP, SSA + (size_t)2 * M, INP(20) + D, INP(24), RTP, CNTP, ws + WS_X8); }
            SEAM(pb + 7);
            if (EN(14) && IN(pb + 8)) { PHASE_ARGS lists_phase(F, RTP, (const unsigned*)CNTP); }
            SEAM(pb + 8);
            if (EN(15) && IN(pb + 9)) { PHASE_ARGS
                unsigned char* rt = RTP;
                pol::PolMoeUp p; p.mt.init((const unsigned*)CNTP); p.init(p.mt.ntiles(), 2 * MFF / 256, F.G, F.bid);
                p.A = (const char*)(ws + WS_X8); p.Bt = (const char*)(R1 + R_MW13); p.list = (const int*)(rt + RT_LIST); p.lr = (const float*)(rt + RT_LR); p.U = R1 + R_U;
                pg8::gemm_phase<pol::PolMoeUp, true>(ring, p);
            }
            SEAM(pb + 9);
#define VCU ((F.G % 8 == 0) ? (F.bid % 8) * (F.G / 8) + F.bid / 8 : F.bid)
            if (EN(16) && IN(pb + 10)) { PHASE_ARGS
                unsigned char* rt = RTP;
                pol::PolMoeDown p; p.mt.init((const unsigned*)CNTP); p.init(p.mt.ntiles(), 4, F.G, VCU);
                const int nun = p.mt.ntiles() * 4, rem = nun % F.G; p.l_off = 0; p.l_end = nun - rem;
                p.A = (const char*)(R1 + R_U); p.Bt = (const char*)(R1 + R_MW2); p.lw = (const float*)(rt + RT_LW); p.Y = (bf16*)(R1 + R_Y);
                pg8::gemm_phase<pol::PolMoeDown, true>(ring, p);
            }
            SEAM(pb + 10);
            if (EN(16) && IN(pb + 11)) { PHASE_ARGS
                unsigned char* rt = RTP; const int vcu = VCU;
                pol::PolMoeDown p; p.mt.init((const unsigned*)CNTP); p.init(p.mt.ntiles(), 4, F.G, vcu);
                const int nun = p.mt.ntiles() * 4, rem = nun % F.G, late_tile = (nun - rem) >> 2; p.l_off = nun - rem; p.l_end = nun;
                p.A = (const char*)(R1 + R_U); p.Bt = (const char*)(R1 + R_MW2); p.lw = (const float*)(rt + RT_LW); p.Y = (bf16*)(R1 + R_Y);
                if (vcu < rem) pg8::gemm_phase<pol::PolMoeDown, true>(ring, p);
                else rows_final(F, (vcu - rem) * NWAVES + F.wave, (F.G - rem) * NWAVES, XBP, (const bf16*)(R1 + R_Y), (const int*)(rt + RT_SL), (const float*)(rt + RT_W), INP(28), OUTP, p.mt.tb[0][8], late_tile, 0);
            }
            SEAM(pb + 11);
        }
    }
    if (EN(17) && IN(22)) { PHASE_ARGS
        pol::MoeTiles mt; mt.init((const unsigned*)((gu32*)(ws + WS_CTL) + CW_CNT)); const int nun = mt.ntiles() * 4, rem = nun % F.G, late_tile = (nun - rem) >> 2;
        if (rem) rows_final(F, F.gw, F.NGW, XBP, (const bf16*)(R1 + R_Y), (const int*)(ws + WS_RT + RT_SL), (const float*)(ws + WS_RT + RT_W), INP(28), OUTP, mt.tb[0][8], late_tile, 1); }
#if MK_TIMING
    {
        volatile LAS unsigned long long* ts = (volatile LAS unsigned long long*)(LDSB + TS_OFF);
        if (blockIdx.x == 0 && threadIdx.x == 0) { const unsigned long long now = __builtin_amdgcn_s_memrealtime(); if (MK_TB1 == NPH) ts[1] = now;
            const unsigned long long target = now + (ts[1] - ts[0]) * 100ull;
            while (__builtin_amdgcn_s_memrealtime() < target) __builtin_amdgcn_s_sleep(32); }
    }
#endif
#undef IN
#undef SEAM
}
#if MK_DEBUG
namespace dbg {
constexpr int TN = 2304, NS = 32, NCK = 33;
__device__ const int SAMP[NS] = {0, 1, 2, 3, 29, 30, 31, 32, 63, 64, 127, 128, 129, 255, 256, 511, 512, 640, 1023, 1024, 1500, 2047, 2048, 2049, 2050, 2079, 2080, 2175, 2176, 2177, 2200, 2303};
__host__ __device__ constexpr int ck_w(int ck) { const int k = ck % 16; return ck == 32 ? 1024 : (k == 0 ? 512 : k <= 3 ? 768 : k <= 5 ? 512 : k == 6 ? 3072 : k == 7 ? 512 : k <= 12 ? 1024 : k == 13 ? 256 : k == 14 ? 512 : 0); }
__host__ __device__ inline size_t ck_off(int ck) { size_t o = 0; for (int i = 0; i < ck; ++i) o += (size_t)NS * ck_w(i); return o; }
constexpr size_t O_X = 0, O_HN = O_X + (size_t)TN * 1024, O_Z = O_HN + (size_t)TN * 1024, O_A0 = O_Z + (size_t)TN * NIN, O_A1 = O_A0 + (size_t)TN * 512, O_A2 = O_A1 + (size_t)TN * 512,
    O_SC = O_A2 + (size_t)TN * 512, O_ST = O_SC + (size_t)TN * 12 * 129, O_OG = O_ST + (size_t)TN * 12 * 2, O_O = O_OG + (size_t)TN * 768, O_C2 = O_O + (size_t)TN * 256,
    O_YA = O_C2 + (size_t)TN * 512, O_YB = O_YA + (size_t)TN * 1024, O_YC = O_YB + (size_t)TN * 1024, O_MRG = O_YC + (size_t)TN * 1024, O_T = O_MRG + (size_t)TN * 1024,
    O_MEMN = O_T + (size_t)TN * 1024, O_KM = O_MEMN + 256 * 1024, O_VM = O_KM + 256 * 1024, O_XS = O_VM + 256 * 1024, O_XO = O_XS + (size_t)TN * 1024,
    O_FA = O_XO + (size_t)TN * 1024, O_FB = O_FA + (size_t)TN * 3584 * 2, O_LG = O_FB + (size_t)TN * 3584 * 2, O_RT = O_LG + (size_t)TN * 8, O_END = O_RT + (size_t)TN * 4;
static_assert(O_END * 4 <= 432 * MiB, "oracle buffers fit R1");

__global__ void k_copy(const float* s, float* d, size_t n) { for (size_t i = blockIdx.x * (size_t)blockDim.x + threadIdx.x; i < n; i += (size_t)gridDim.x * blockDim.x) d[i] = s[i]; }
__global__ void k_rms(const float* x, const float* g, float* o, int rows) {
    __shared__ float red[256];
    for (int r = blockIdx.x; r < rows; r += gridDim.x) { float s = 0.f; for (int c = threadIdx.x; c < 1024; c += 256) { const float v = x[(size_t)r * 1024 + c]; s += v * v; }
        red[threadIdx.x] = s; __syncthreads(); for (int o2 = 128; o2 > 0; o2 >>= 1) { if ((int)threadIdx.x < o2) red[threadIdx.x] += red[threadIdx.x + o2]; __syncthreads(); }
        const float rs = 1.f / sqrtf(red[0] / 1024.f + EPS); __syncthreads();
        for (int c = threadIdx.x; c < 1024; c += 256) o[(size_t)r * 1024 + c] = x[(size_t)r * 1024 + c] * rs * g[c]; }
}
__global__ void k_gemm(const float* A, int lda, const float* W, int ldw, const float* bias, float* C, int ldc, int rows, int N, int K) {
    const size_t tot = (size_t)rows * N;
    for (size_t i = blockIdx.x * (size_t)blockDim.x + threadIdx.x; i < tot; i += (size_t)gridDim.x * blockDim.x) { const int r = (int)(i / N), n = (int)(i % N); float acc = 0.f;
        for (int k = 0; k < K; ++k) acc += A[(size_t)r * lda + k] * W[(size_t)k * ldw + n];
        C[(size_t)r * ldc + n] = acc + (bias ? bias[n] : 0.f); }
}
__device__ inline float sigm(float x) { return 1.f / (1.f + expf(-x)); }
__global__ void k_glu(const float* z, float* a0) { for (int i = blockIdx.x * blockDim.x + threadIdx.x; i < TN * 512; i += gridDim.x * blockDim.x) { const int t = i / 512, c = i % 512; a0[i] = z[(size_t)t * NIN + c] * sigm(z[(size_t)t * NIN + 512 + c]); } }
__global__ void k_conv31(const float* a0, const float* w, const float* b, float* a1) { for (int i = blockIdx.x * blockDim.x + threadIdx.x; i < TN * 512; i += gridDim.x * blockDim.x) { const int t = i / 512, c = i % 512; float s = b[c];
        for (int k = 0; k < 31; ++k) { const int tt = t - 30 + k; if (tt >= 0) s += w[k * 512 + c] * a0[(size_t)tt * 512 + c]; } a1[i] = s; } }
__global__ void k_ln_silu(const float* a1, const float* g, const float* b, float* a2) {
    __shared__ float red[256];
    for (int r = blockIdx.x; r < TN; r += gridDim.x) { const float v0 = a1[(size_t)r * 512 + threadIdx.x], v1 = a1[(size_t)r * 512 + 256 + threadIdx.x];
        red[threadIdx.x] = v0 + v1; __syncthreads(); for (int o2 = 128; o2 > 0; o2 >>= 1) { if ((int)threadIdx.x < o2) red[threadIdx.x] += red[threadIdx.x + o2]; __syncthreads(); }
        const float mu = red[0] / 512.f; __syncthreads(); const float d0 = v0 - mu, d1 = v1 - mu;
        red[threadIdx.x] = d0 * d0 + d1 * d1; __syncthreads(); for (int o2 = 128; o2 > 0; o2 >>= 1) { if ((int)threadIdx.x < o2) red[threadIdx.x] += red[threadIdx.x + o2]; __syncthreads(); }
        const float rs = 1.f / sqrtf(red[0] / 512.f + EPS); __syncthreads();
        const float y0 = d0 * rs * g[threadIdx.x] + b[threadIdx.x], y1 = d1 * rs * g[256 + threadIdx.x] + b[256 + threadIdx.x];
        a2[(size_t)r * 512 + threadIdx.x] = y0 * sigm(y0); a2[(size_t)r * 512 + 256 + threadIdx.x] = y1 * sigm(y1); }
}
__global__ void k_scores(const float* z, float* sc) {
    for (int i = blockIdx.x * blockDim.x + threadIdx.x; i < TN * 12 * 129; i += gridDim.x * blockDim.x) { const int j = i % 129, gh = (i / 129) % 12, t = i / (129 * 12), g = gh / 4; const int d = g == 0 ? 1 : (g == 1 ? 4 : 16);
        const int tk = t - j * d; float s = -__builtin_inff();
        if (tk >= 0) { s = 0.f; for (int e = 0; e < 64; ++e) s += z[(size_t)t * NIN + OFF_Q + gh * 64 + e] * z[(size_t)tk * NIN + OFF_K + gh * 64 + e]; s *= 0.125f; }
        sc[i] = s; }
}
__global__ void k_attn_stats(const float* sc, float* st) { for (int i = blockIdx.x * blockDim.x + threadIdx.x; i < TN * 12; i += gridDim.x * blockDim.x) { float mx = -__builtin_inff(); for (int j = 0; j < 129; ++j) mx = fmaxf(mx, sc[(size_t)i * 129 + j]);
        float den = 0.f; for (int j = 0; j < 129; ++j) den += expf(sc[(size_t)i * 129 + j] - mx); st[2 * i] = mx; st[2 * i + 1] = den; } }
__global__ void k_attn_out(const float* sc, const float* st, const float* z, float* og) {
    for (int i = blockIdx.x * blockDim.x + threadIdx.x; i < TN * 768; i += gridDim.x * blockDim.x) { const int t = i / 768, c = i % 768, gh = c / 64, g = gh / 4; const int d = g == 0 ? 1 : (g == 1 ? 4 : 16);
        const float mx = st[2 * (t * 12 + gh)], den = st[2 * (t * 12 + gh) + 1]; float o = 0.f;
        for (int j = 0; j < 129; ++j) { const int tk = t - j * d; if (tk >= 0) o += expf(sc[((size_t)t * 12 + gh) * 129 + j] - mx) / den * z[(size_t)tk * NIN + OFF_V + c]; }
        og[i] = o; }
}
__global__ void k_attn_merge(const float* og, const float* st, float* o) { for (int i = blockIdx.x * blockDim.x + threadIdx.x; i < TN * 256; i += gridDim.x * blockDim.x) { const int t = i / 256, c = i % 256, h = c / 64;
        float l[3], mx = -__builtin_inff(); for (int g = 0; g < 3; ++g) { l[g] = st[2 * (t * 12 + g * 4 + h)] + logf(st[2 * (t * 12 + g * 4 + h) + 1]); mx = fmaxf(mx, l[g]); }
        float den = 0.f, acc = 0.f; for (int g = 0; g < 3; ++g) { const float w = expf(l[g] - mx); den += w; acc += w * og[(size_t)t * 768 + g * 256 + c]; } o[i] = acc / den; } }
__global__ void k_shortconv(const float* z, const float* w, float* c2) { for (int i = blockIdx.x * blockDim.x + threadIdx.x; i < TN * 512; i += gridDim.x * blockDim.x) { const int t = i / 512, c = i % 512; float s = 0.f;
        for (int k = 0; k < 3; ++k) { const int tt = t - 2 + k; if (tt >= 0) s += w[k * 512 + c] * z[(size_t)tt * NIN + OFF_CC + c] * z[(size_t)tt * NIN + OFF_CH + c]; } c2[i] = z[(size_t)t * NIN + OFF_CB + c] * s; } }
__global__ void k_merge(const float* z, const float* ya, const float* yb, const float* yc, float* m) { for (int i = blockIdx.x * blockDim.x + threadIdx.x; i < TN * 1024; i += gridDim.x * blockDim.x) { const int t = i / 1024, c = i % 1024;
        m[i] = sigm(z[(size_t)t * NIN + OFF_G + c]) * ya[i] + sigm(z[(size_t)t * NIN + OFF_G + 1024 + c]) * yb[i] + sigm(z[(size_t)t * NIN + OFF_G + 2048 + c]) * yc[i]; } }
__global__ void k_add(float* x, const float* y, size_t n) { for (size_t i = blockIdx.x * (size_t)blockDim.x + threadIdx.x; i < n; i += (size_t)gridDim.x * blockDim.x) x[i] += y[i]; }
__global__ void k_xscores(const float* q, const float* km, float* s) {
    for (int i = blockIdx.x * blockDim.x + threadIdx.x; i < TN * 1024; i += gridDim.x * blockDim.x) { const int t = i / 1024, h = (i / 256) % 4, key = i % 256; float a = 0.f;
        for (int e = 0; e < 256; ++e) a += q[(size_t)t * 1024 + h * 256 + e] * km[(size_t)key * 1024 + h * 256 + e]; s[i] = a * 0.0625f; } }
__global__ void k_softmax256(float* s, int rows) { for (int r = blockIdx.x * blockDim.x + threadIdx.x; r < rows; r += gridDim.x * blockDim.x) { float mx = -__builtin_inff(); for (int j = 0; j < 256; ++j) mx = fmaxf(mx, s[(size_t)r * 256 + j]);
        float den = 0.f; for (int j = 0; j < 256; ++j) den += expf(s[(size_t)r * 256 + j] - mx); for (int j = 0; j < 256; ++j) s[(size_t)r * 256 + j] = expf(s[(size_t)r * 256 + j] - mx) / den; } }
__global__ void k_xout(const float* p, const float* vm, float* o) { for (int i = blockIdx.x * blockDim.x + threadIdx.x; i < TN * 1024; i += gridDim.x * blockDim.x) { const int t = i / 1024, n = i % 1024, h = n / 256; float a = 0.f;
        for (int key = 0; key < 256; ++key) a += p[(size_t)t * 1024 + h * 256 + key] * vm[(size_t)key * 1024 + n]; o[i] = a; } }
__global__ void k_swiglu(const float* a, const float* b, float* u, size_t n) { for (size_t i = blockIdx.x * (size_t)blockDim.x + threadIdx.x; i < n; i += (size_t)gridDim.x * blockDim.x) u[i] = a[i] * sigm(a[i]) * b[i]; }
__global__ void k_top2(const float* lg, float* rt) { for (int t = blockIdx.x * blockDim.x + threadIdx.x; t < TN; t += gridDim.x * blockDim.x) { int e1 = 0; float v1 = lg[t * 8]; for (int e = 1; e < 8; ++e) if (lg[t * 8 + e] > v1) { v1 = lg[t * 8 + e]; e1 = e; }
        int e2 = -1; float v2 = -3.0e38f; for (int e = 0; e < 8; ++e) if (e != e1 && lg[t * 8 + e] > v2) { v2 = lg[t * 8 + e]; e2 = e; }
        const float w1 = 1.f / (1.f + expf(v2 - v1)); rt[t * 4] = (float)e1; rt[t * 4 + 1] = (float)e2; rt[t * 4 + 2] = w1; rt[t * 4 + 3] = 1.f - w1; } }
__global__ void k_moe_up(const float* hn, const float* rt, const float* w1, const float* w3, float* u) {
    for (size_t i = blockIdx.x * (size_t)blockDim.x + threadIdx.x; i < (size_t)TN * 2 * MFF; i += (size_t)gridDim.x * blockDim.x) { const int j = (int)(i % MFF), p = (int)((i / MFF) % 2), t = (int)(i / (2 * MFF)); const int e = (int)rt[t * 4 + p];
        const float* a1 = w1 + (size_t)e * D * MFF + j; const float* a3 = w3 + (size_t)e * D * MFF + j; float a = 0.f, b = 0.f;
        for (int k = 0; k < D; ++k) { const float h = hn[(size_t)t * D + k]; a += h * a1[(size_t)k * MFF]; b += h * a3[(size_t)k * MFF]; } u[i] = a * sigm(a) * b; } }
__global__ void k_moe_down(const float* u, const float* rt, const float* w2, float* y) { for (int i = blockIdx.x * blockDim.x + threadIdx.x; i < TN * D; i += gridDim.x * blockDim.x) { const int t = i / D, n = i % D; float acc = 0.f;
        for (int p = 0; p < 2; ++p) { const int e = (int)rt[t * 4 + p]; float a = 0.f; for (int j = 0; j < MFF; ++j) a += u[((size_t)t * 2 + p) * MFF + j] * w2[((size_t)e * MFF + j) * D + n]; acc += rt[t * 4 + 2 + p] * a; } y[i] = acc; } }
__global__ void k_sample(const float* src, int ld, int col0, int width, float scale, float* gold, int mode, int col1) {
    for (int i = blockIdx.x * blockDim.x + threadIdx.x; i < NS * width; i += gridDim.x * blockDim.x) { const int s = i / width, c = i % width; const float v = src[(size_t)SAMP[s] * ld + col0 + c];
        gold[i] = mode == 0 ? v * scale : (mode == 1 ? sigm(v) : v * src[(size_t)SAMP[s] * ld + col1 + c]); } }
__global__ void k_check(const void* mainp, int is_bf16, int ld, int col0, const float* gold, int gld, int gcol0, int width, float* chk) {
    __shared__ float rd[256], rg[256]; float d2 = 0.f, g2 = 0.f;
    for (int i = threadIdx.x; i < NS * width; i += 256) { const int s = i / width, c = i % width; const size_t o = (size_t)SAMP[s] * ld + col0 + c;
        const float v = is_bf16 ? bf2f(((const bf16*)mainp)[o]) : ((const float*)mainp)[o]; const float g = gold[(size_t)s * gld + gcol0 + c]; const float df = v - g; d2 += (df == df) ? df * df : 1.0e30f; g2 += g * g; }
    rd[threadIdx.x] = d2; rg[threadIdx.x] = g2; __syncthreads();
    for (int o2 = 128; o2 > 0; o2 >>= 1) { if ((int)threadIdx.x < o2) { rd[threadIdx.x] += rd[threadIdx.x + o2]; rg[threadIdx.x] += rg[threadIdx.x + o2]; } __syncthreads(); }
    if (threadIdx.x == 0) *chk = sqrtf(rd[0] / fmaxf(rg[0], 1e-30f));
}
__global__ void k_encode(float* out, const float* chk, float tol) {
    int bad = -1; for (int k = 0; k < NCK; ++k) if ((k == 32 || (k % 16) < 13) && !(chk[k] <= tol)) { bad = k; break; }
    if (bad < 0) return;
    const float c = exp2f((float)(bad + 1));
    for (size_t i = blockIdx.x * (size_t)blockDim.x + threadIdx.x; i < (size_t)M * D; i += (size_t)gridDim.x * blockDim.x) out[i] = c;
}
__global__ void k_detail(float* out, const void* mainp, int ld, int col0, const float* gold, int gld, int gcol0, int ntile, float tol, float* res) {
    __shared__ int first, cnt; if (threadIdx.x == 0) { first = 1 << 30; cnt = 0; } __syncthreads();
    for (int p = threadIdx.x; p < NS * ntile; p += blockDim.x) { const int s2 = p / ntile, t = p % ntile; float d2 = 0.f, g2 = 0.f;
        for (int c = 0; c < 256; ++c) { const float v = bf2f(((const bf16*)mainp)[(size_t)SAMP[s2] * ld + col0 + t * 256 + c]), g = gold[(size_t)s2 * gld + gcol0 + t * 256 + c]; const float df = v - g; d2 += (df == df) ? df * df : 1e30f; g2 += g * g; }
        if (!(sqrtf(d2 / fmaxf(g2, 1e-30f)) <= tol)) { atomicMin(&first, p); atomicAdd(&cnt, 1); } }
    __syncthreads();
    if (threadIdx.x == 0) { res[0] = (float)first; res[1] = (float)cnt; }
}
__global__ void k_detail_fill(float* out, const float* res) {
    const int first = (int)res[0], cnt = (int)res[1]; if (cnt == 0) return;
    const int cls = cnt <= 1 ? 0 : (cnt <= 4 ? 1 : (cnt <= 16 ? 2 : 3));
    const float c = exp2f(0.5f * (float)(first + 1)) * (1.f + 0.1f * cls);
    for (size_t i = blockIdx.x * (size_t)blockDim.x + threadIdx.x; i < (size_t)M * D; i += (size_t)gridDim.x * blockDim.x) out[i] = c;
}
}

static void dbg_oracle(const Args& a, hipStream_t st) {
    using namespace dbg;
    float* O = (float*)(a.ws + WS_R1); float* gold = (float*)(a.ws + WS_DBG);
    const dim3 g(1024), b(256);
#define SAMPLE(src, ld, c0, ck, sc) k_sample<<<64, 256, 0, st>>>(src, ld, c0, ck_w(ck), sc, gold + ck_off(ck), 0, 0)
#define SAMPLEM(src, ld, c0, ck, mode, c1) k_sample<<<64, 256, 0, st>>>(src, ld, c0, ck_w(ck), 1.f, gold + ck_off(ck), mode, c1)
    k_copy<<<g, b, 0, st>>>(a.in[0], O + O_X, (size_t)TN * 1024);
    for (int l = 0; l < 2; ++l) {
        const int cb = 16 * l;
        k_rms<<<g, b, 0, st>>>(O + O_X, a.in[2] + l * 1024, O + O_HN, TN);
        k_gemm<<<g, b, 0, st>>>(O + O_HN, 1024, a.in[3] + (size_t)l * 1024 * NIN, NIN, a.in[4] + l * NIN, O + O_Z, NIN, TN, NIN, 1024);
        k_glu<<<g, b, 0, st>>>(O + O_Z, O + O_A0);
        k_conv31<<<g, b, 0, st>>>(O + O_A0, a.in[5] + l * 31 * 512, a.in[6] + l * 512, O + O_A1);
        k_ln_silu<<<g, b, 0, st>>>(O + O_A1, a.in[7] + l * 512, a.in[8] + l * 512, O + O_A2);
        k_scores<<<g, b, 0, st>>>(O + O_Z, O + O_SC);
        k_attn_stats<<<g, b, 0, st>>>(O + O_SC, O + O_ST);
        k_attn_out<<<g, b, 0, st>>>(O + O_SC, O + O_ST, O + O_Z, O + O_OG);
        k_attn_merge<<<g, b, 0, st>>>(O + O_OG, O + O_ST, O + O_O);
        k_shortconv<<<g, b, 0, st>>>(O + O_Z, a.in[11] + l * 3 * 512, O + O_C2);
        SAMPLE(O + O_A0, 512, 0, cb + 0, 1.f); SAMPLE(O + O_Z, NIN, OFF_Q, cb + 1, C2); SAMPLE(O + O_Z, NIN, OFF_K, cb + 2, 1.f); SAMPLE(O + O_Z, NIN, OFF_V, cb + 3, 1.f); SAMPLE(O + O_Z, NIN, OFF_CB, cb + 4, 1.f);
        SAMPLEM(O + O_Z, NIN, OFF_CC, cb + 5, 2, OFF_CH); SAMPLEM(O + O_Z, NIN, OFF_G, cb + 6, 1, 0);
        SAMPLE(O + O_A2, 512, 0, cb + 7, 1.f); SAMPLE(O + O_O, 256, 0, cb + 13, 1.f); SAMPLE(O + O_C2, 512, 0, cb + 14, 1.f);
        k_gemm<<<g, b, 0, st>>>(O + O_A2, 512, a.in[9] + (size_t)l * 512 * 1024, 1024, nullptr, O + O_YA, 1024, TN, 1024, 512);
        k_gemm<<<g, b, 0, st>>>(O + O_O, 256, a.in[10] + (size_t)l * 256 * 1024, 1024, nullptr, O + O_YB, 1024, TN, 1024, 256);
        k_gemm<<<g, b, 0, st>>>(O + O_C2, 512, a.in[12] + (size_t)l * 512 * 1024, 1024, nullptr, O + O_YC, 1024, TN, 1024, 512);
        k_merge<<<g, b, 0, st>>>(O + O_Z, O + O_YA, O + O_YB, O + O_YC, O + O_MRG);
        SAMPLE(O + O_MRG, 1024, 0, cb + 8, 1.f);
        k_gemm<<<g, b, 0, st>>>(O + O_MRG, 1024, a.in[13] + (size_t)l * 1024 * 1024, 1024, nullptr, O + O_T, 1024, TN, 1024, 1024);
        k_add<<<g, b, 0, st>>>(O + O_X, O + O_T, (size_t)TN * 1024);
        SAMPLE(O + O_X, 1024, 0, cb + 9, 1.f);
        k_rms<<<g, b, 0, st>>>(O + O_X, a.in[14] + l * 1024, O + O_HN, TN);
        k_gemm<<<g, b, 0, st>>>(O + O_HN, 1024, a.in[16] + (size_t)l * 1024 * 1024, 1024, nullptr, O + O_T, 1024, TN, 1024, 1024);
        k_rms<<<g, b, 0, st>>>(a.in[1], a.in[15] + l * 1024, O + O_MEMN, 256);
        k_gemm<<<g, b, 0, st>>>(O + O_MEMN, 1024, a.in[17] + (size_t)l * 1024 * 1024, 1024, nullptr, O + O_KM, 1024, 256, 1024, 1024);
        k_gemm<<<g, b, 0, st>>>(O + O_MEMN, 1024, a.in[18] + (size_t)l * 1024 * 1024, 1024, nullptr, O + O_VM, 1024, 256, 1024, 1024);
        k_xscores<<<g, b, 0, st>>>(O + O_T, O + O_KM, O + O_XS);
        k_softmax256<<<g, b, 0, st>>>(O + O_XS, TN * 4);
        SAMPLE(O + O_XS, 1024, 0, cb + 10, 1.f);
        k_xout<<<g, b, 0, st>>>(O + O_XS, O + O_VM, O + O_XO);
        k_gemm<<<g, b, 0, st>>>(O + O_XO, 1024, a.in[19] + (size_t)l * 1024 * 1024, 1024, nullptr, O + O_T, 1024, TN, 1024, 1024);
        k_add<<<g, b, 0, st>>>(O + O_X, O + O_T, (size_t)TN * 1024);
        SAMPLE(O + O_X, 1024, 0, cb + 11, 1.f);
        k_rms<<<g, b, 0, st>>>(O + O_X, a.in[20] + l * 1024, O + O_HN, TN);
        if (l == 0) {
            k_gemm<<<g, b, 0, st>>>(O + O_HN, 1024, a.in[21], DFF, nullptr, O + O_FA, DFF, TN, DFF, 1024);
            k_gemm<<<g, b, 0, st>>>(O + O_HN, 1024, a.in[22], DFF, nullptr, O + O_FB, DFF, TN, DFF, 1024);
            k_swiglu<<<g, b, 0, st>>>(O + O_FA, O + O_FB, O + O_FA, (size_t)TN * DFF);
            k_gemm<<<g, b, 0, st>>>(O + O_FA, DFF, a.in[23], 1024, nullptr, O + O_T, 1024, TN, 1024, DFF);
        } else {
            k_gemm<<<g, b, 0, st>>>(O + O_HN, 1024, a.in[24], 8, nullptr, O + O_LG, 8, TN, 8, 1024);
            k_top2<<<g, b, 0, st>>>(O + O_LG, O + O_RT);
            k_moe_up<<<g, b, 0, st>>>(O + O_HN, O + O_RT, a.in[25], a.in[26], O + O_FA);
            k_moe_down<<<g, b, 0, st>>>(O + O_FA, O + O_RT, a.in[27], O + O_T);
        }
        k_add<<<g, b, 0, st>>>(O + O_X, O + O_T, (size_t)TN * 1024);
        SAMPLE(O + O_X, 1024, 0, cb + 12, 1.f);
    }
    k_rms<<<g, b, 0, st>>>(O + O_X, a.in[28], O + O_HN, TN);
    SAMPLE(O + O_HN, 1024, 0, 32, 1.f);
#undef SAMPLE
#undef SAMPLEM
}
static void dbg_check(const Args& a, int ph, hipStream_t st) {
    using namespace dbg;
    const unsigned char* R1 = a.ws + WS_R1; const float* gold = (const float*)(a.ws + WS_DBG); float* chk = (float*)(a.ws + WS_CTL) + CW_CHK;
#define CHECK(ptr, isb, ld, c0, ck) k_check<<<1, 256, 0, st>>>(ptr, isb, ld, c0, gold + ck_off(ck), ck_w(ck), 0, ck_w(ck), chk + (ck))
    for (int l = 0; l < 2; ++l) { const int pb = l == 0 ? 1 : 10, cb = 16 * l;
        if (ph == pb + 0) { CHECK(R1 + R_AG, 1, 512, 0, cb + 0); CHECK(R1 + R_Q, 1, 768, 0, cb + 1); CHECK(R1 + R_K, 1, 768, 0, cb + 2); CHECK(R1 + R_V, 1, 768, 0, cb + 3); CHECK(R1 + R_GB, 1, 512, 0, cb + 4);
                            CHECK(R1 + R_CP, 1, 512, 0, cb + 5);
 }
        if (ph == pb + 2) { CHECK(R1 + R_ACT, 1, KCAT, 0, cb + 7); CHECK(R1 + R_ACT, 1, KCAT, 512, cb + 13); CHECK(R1 + R_ACT, 1, KCAT, 768, cb + 14); }
        if (ph == pb + 3) { CHECK(R1 + R_MRG, 1, 1024, 0, cb + 8); }
        if (ph == pb + 4) { CHECK(a.ws + WS_XB, 1, 1024, 0, cb + 9); }
        if (ph == pb + 5) {   }
        if (ph == pb + 6) { CHECK(a.ws + WS_XB, 1, 1024, 0, cb + 11); }
        if (l == 0 && ph == pb + 8) { CHECK(a.ws + WS_XB, 1, 1024, 0, cb + 12); }

    }
    if (ph == 1) k_detail<<<1, 128, 0, st>>>(a.out, R1 + R_G, 3072, 0, gold + ck_off(6), 3072, 0, 4, 0.03f, chk + 50);
    if (ph == 22) CHECK(a.out, 0, 1024, 0, 32);
#undef CHECK
}
static void dbg_encode(const Args& a, hipStream_t st) { dbg::k_encode<<<1024, 256, 0, st>>>(a.out, (const float*)(a.ws + WS_CTL) + CW_CHK, 0.03f);
#ifdef MK_DETAIL
    dbg::k_detail_fill<<<1024, 256, 0, st>>>(a.out, (const float*)(a.ws + WS_CTL) + CW_CHK + 50);
#endif
}
#endif
extern "C" void kernel_launch(void* const* d_in, const int* in_sizes, int n_in, void* d_out, int out_size, void* d_ws, size_t ws_size, hipStream_t stream) {
    static int grid = 0;
    if (grid == 0) {
        if (n_in != 29 || in_sizes[0] != M * D || out_size != M * D || ws_size < WS_END) {
            fprintf(stderr, "kernel_launch: built for 29 inputs, x/out of %d floats, >= %zu bytes of workspace; got n_in %d, in0 %d, out %d, ws %zu; nothing launched\n", M * D, (size_t)WS_END, n_in, n_in > 0 ? in_sizes[0] : -1, out_size, ws_size);
            grid = -1; return; }
        int dev = 0, cus = 0, per_cu = 0;
        if (hipGetDevice(&dev) != hipSuccess || hipDeviceGetAttribute(&cus, hipDeviceAttributeMultiprocessorCount, dev) != hipSuccess) { grid = -1; return; }
        if (hipFuncSetAttribute((const void*)mk_fwd, hipFuncAttributeMaxDynamicSharedMemorySize, LDS_BYTES) != hipSuccess) { fprintf(stderr, "kernel_launch: hipFuncSetAttribute failed\n"); grid = -1; return; }
        if (hipOccupancyMaxActiveBlocksPerMultiprocessor(&per_cu, (const void*)mk_fwd, NTHR, LDS_BYTES) != hipSuccess || per_cu < 1) { fprintf(stderr, "kernel_launch: occupancy query reports %d blocks per CU\n", per_cu); per_cu = 1; }
        (void)hipGetLastError();
        grid = cus;
    }
    if (grid < 0) return;
    if (hipMemsetAsync((char*)d_ws + WS_CTL, 0, CTL_ZERO_BYTES, stream) != hipSuccess) return;
    Args a{};
    for (int i = 0; i < 29; ++i) a.in[i] = (const float*)d_in[i];
    a.out = (float*)d_out; a.ws = (unsigned char*)d_ws;
#if MK_DEBUG
    dbg_oracle(a, stream);
#endif
#if MK_ONE_LAUNCH && !MK_DEBUG
    a.ph_lo = 0; a.ph_hi = NPH;
    hipLaunchKernelGGL(mk_fwd, dim3(grid), dim3(NTHR), LDS_BYTES, stream, a);
#else
    for (int ph = 0; ph < NPH; ++ph) {
        a.ph_lo = ph; a.ph_hi = ph + 1;
        hipLaunchKernelGGL(mk_fwd, dim3(grid), dim3(NTHR), LDS_BYTES, stream, a);
#if MK_DEBUG
        dbg_check(a, ph, stream);
#endif
    }
#endif
#if MK_DEBUG
    dbg_encode(a, stream);
#endif
}
```
